# Optimizing an MI355X kernel written in HIP

```python
import math
import jax, jax.numpy as jnp
from jax import lax
import numpy as np

D_MODEL = 1024
BATCH = 4
SEQ = 4096
DEPTH = 4
DEC_BATCH = 32
DEC_SEQ = 64
PAST_LEN = 2048

CHUNK = 64
Q_BLOCK = 128
N_MEM = 256
D_FF = 4096
EPS = 1e-6

SSM_WIDTH = 256
SSM_GROUP = 16
SSM_GROUPS = SSM_WIDTH // SSM_GROUP
SSM_STATE = 64
SSM_DT_MIN = 1e-3
SSM_DT_MAX = 1e-1
ATT_HEADS = 4
ATT_HEAD_DIM = 64
ATT_HALF = ATT_HEAD_DIM // 2
ATT_WIDTH = ATT_HEADS * ATT_HEAD_DIM
CONV_WIDTH = 256
CONV_K = 31
GMLP_WIDTH = 256
GMLP_HEADS = 4
GMLP_HEAD_DIM = GMLP_WIDTH // GMLP_HEADS
GMLP_CHUNK = 128
X_HEADS = 4
X_HEAD_DIM = 128
X_WIDTH = X_HEADS * X_HEAD_DIM

OFF_SSM = 0
OFF_Q = OFF_SSM + SSM_WIDTH
OFF_K = OFF_Q + ATT_WIDTH
OFF_V = OFF_K + ATT_WIDTH
OFF_CONV = OFF_V + ATT_WIDTH
OFF_GMLP = OFF_CONV + 2 * CONV_WIDTH
IN_WIDTH = OFF_GMLP + 2 * GMLP_WIDTH
MIX_WIDTH = SSM_WIDTH + ATT_WIDTH + CONV_WIDTH + GMLP_WIDTH

kernel_name = 'hybrid_streaming_encoder_step'


def rms_norm(x, g):
    xf = x.astype(jnp.float32)
    y = xf * lax.rsqrt(jnp.mean(xf * xf, axis=-1, keepdims=True) + EPS)
    return (y * g.astype(jnp.float32)).astype(x.dtype)


def layer_norm(x, g, b):
    xf = x.astype(jnp.float32)
    mu = jnp.mean(xf, axis=-1, keepdims=True)
    var = jnp.mean(jnp.square(xf - mu), axis=-1, keepdims=True)
    y = (xf - mu) * lax.rsqrt(var + EPS) * g.astype(jnp.float32) + b.astype(jnp.float32)
    return y.astype(x.dtype)


def swiglu_ffn(h, w_gate, w_up, w_down):
    return (jax.nn.silu(h @ w_gate) * (h @ w_up)) @ w_down


def s5_mixer(u, s0_re, s0_im, a_re, a_im, b_re, b_im, c_re, c_im, d, log_dt, w_glu, b_glu):
    f32 = jnp.float32
    bt, t, _ = u.shape
    ug = u.astype(f32).reshape(bt, t, SSM_GROUPS, SSM_GROUP)
    lam = lax.complex(a_re.astype(f32), a_im.astype(f32))
    dt = jnp.exp(log_dt.astype(f32))[:, None]
    a_bar = jnp.exp(lam * dt)
    b_c = lax.complex(b_re.astype(f32), b_im.astype(f32))
    b_bar = ((a_bar - 1.0) / lam)[..., None] * b_c
    bu = jnp.einsum('btgc,gpc->btgp', ug.astype(jnp.complex64), b_bar)
    a_seq = jnp.broadcast_to(a_bar, bu.shape)

    def combine(e1, e2):
        return e1[0] * e2[0], e2[0] * e1[1] + e2[1]

    a_cum, s = lax.associative_scan(combine, (a_seq, bu), axis=1)
    s0 = lax.complex(s0_re.astype(f32), s0_im.astype(f32))
    s = s + a_cum * s0[:, None]
    c_c = lax.complex(c_re.astype(f32), c_im.astype(f32))
    y = jnp.real(jnp.einsum('btgp,gcp->btgc', s, c_c)) + d.astype(f32) * ug
    y = y.reshape(bt, t, SSM_WIDTH)
    g = jax.nn.gelu(y)
    out = g * jax.nn.sigmoid(g @ w_glu.astype(f32) + b_glu.astype(f32))
    s_last = s[:, -1]
    return out.astype(u.dtype), jnp.real(s_last).astype(s0_re.dtype), jnp.imag(s_last).astype(s0_re.dtype)


def alibi_slopes():
    return 2.0 ** (-8.0 * jnp.arange(1, ATT_HEADS + 1, dtype=jnp.float32) / ATT_HEADS)


def diff_attention(q, k, v, q_pos, k_pos, lam, lam_init, g_head):
    f32 = jnp.float32
    bt, tq = q.shape[0], q.shape[1]
    blk = min(tq, Q_BLOCK)
    nblk = tq // blk
    kf = k.astype(f32)
    vf = v.astype(f32)
    k1, k2 = kf[..., :ATT_HALF], kf[..., ATT_HALF:]
    slopes = alibi_slopes()
    k_chunk = k_pos // CHUNK
    scale = ATT_HALF ** -0.5

    def block(args):
        qb, qp = args
        qb = qb.astype(f32) * scale
        dist = jnp.abs(qp[:, None] - k_pos[None, :]).astype(f32)
        visible = k_chunk[None, :] <= (qp // CHUNK)[:, None]
        bias = jnp.where(visible[None], -slopes[:, None, None] * dist[None], -jnp.inf)
        a1 = jax.nn.softmax(jnp.einsum('bqhd,bkhd->bhqk', qb[..., :ATT_HALF], k1) + bias, axis=-1)
        a2 = jax.nn.softmax(jnp.einsum('bqhd,bkhd->bhqk', qb[..., ATT_HALF:], k2) + bias, axis=-1)
        return jnp.einsum('bhqk,bkhd->bqhd', a1 - lam * a2, vf)

    qb = q.reshape(bt, nblk, blk, ATT_HEADS, ATT_HEAD_DIM).transpose(1, 0, 2, 3, 4)
    qpb = q_pos.reshape(nblk, blk)
    o = lax.map(block, (qb, qpb))
    o = o.transpose(1, 0, 2, 3, 4).reshape(bt, tq, ATT_HEADS, ATT_HEAD_DIM)
    o = o * lax.rsqrt(jnp.mean(o * o, axis=-1, keepdims=True) + EPS) * g_head.astype(f32)
    o = o * (1.0 - lam_init)
    return o.reshape(bt, tq, ATT_WIDTH).astype(q.dtype)


def causal_depthwise_conv(z, buf, w, b):
    zp = jnp.concatenate([buf.astype(z.dtype), z], axis=1)
    y = lax.conv_general_dilated(zp, w[:, None, :].astype(z.dtype), window_strides=(1,), padding='VALID',
                                 dimension_numbers=('NWC', 'WIO', 'NWC'), feature_group_count=z.shape[-1])
    return y + b.astype(z.dtype), zp[:, -(CONV_K - 1):]


def conformer_conv(p, buf, w, b, ln_g, ln_b, w_pw):
    z = p[..., :CONV_WIDTH] * jax.nn.sigmoid(p[..., CONV_WIDTH:])
    y, new_buf = causal_depthwise_conv(z, buf, w, b)
    y = jax.nn.silu(layer_norm(y, ln_g, ln_b))
    return y @ w_pw, new_buf


def chunk_spatial_gating(p, ln_g, ln_b, ws, bs):
    bt, t, _ = p.shape
    z = jax.nn.gelu(p)
    u, v = z[..., :GMLP_WIDTH], z[..., GMLP_WIDTH:]
    v = layer_norm(v, ln_g, ln_b)
    L = min(t, GMLP_CHUNK)
    nc = t // L
    mask = jnp.tril(jnp.ones((L, L), dtype=bool))
    w = jnp.where(mask, ws[:, :L, :L], 0.0).astype(v.dtype)
    vc = v.reshape(bt, nc, L, GMLP_HEADS, GMLP_HEAD_DIM)
    mixed = jnp.einsum('hij,bcjhd->bcihd', w, vc) + bs[:, :L].T.astype(v.dtype)[None, None, :, :, None]
    return u * mixed.reshape(bt, t, GMLP_WIDTH), v


def memory_cross_attention(h, mem_k, mem_v, wq, wo):
    f32 = jnp.float32
    bt, t, _ = h.shape
    q = (h @ wq).reshape(bt, t, X_HEADS, X_HEAD_DIM).astype(f32) * (X_HEAD_DIM ** -0.5)
    a = jax.nn.softmax(jnp.einsum('bqhd,bkhd->bhqk', q, mem_k.astype(f32)), axis=-1)
    o = jnp.einsum('bhqk,bkhd->bqhd', a, mem_v.astype(f32)).reshape(bt, t, X_WIDTH)
    return o.astype(h.dtype) @ wo


def encoder_layer(x, prm, lam_init, attn_past, s0_re, s0_im, conv_buf, mem_k, mem_v):
    f32 = jnp.float32
    bt, t, _ = x.shape
    x = x + 0.5 * swiglu_ffn(rms_norm(x, prm['ffn1_norm']), prm['ffn1_w_gate'], prm['ffn1_w_up'], prm['ffn1_w_down'])
    h = rms_norm(x, prm['mix_norm'])
    proj = h @ prm['w_in']
    a_out, s_re, s_im = s5_mixer(proj[..., OFF_SSM:OFF_Q], s0_re, s0_im, prm['ssm_a_re'], prm['ssm_a_im'],
                                 prm['ssm_b_re'], prm['ssm_b_im'], prm['ssm_c_re'], prm['ssm_c_im'],
                                 prm['ssm_d'], prm['ssm_log_dt'], prm['ssm_w_glu'], prm['ssm_b_glu'])
    q = proj[..., OFF_Q:OFF_K].reshape(bt, t, ATT_HEADS, ATT_HEAD_DIM)
    k = proj[..., OFF_K:OFF_V].reshape(bt, t, ATT_HEADS, ATT_HEAD_DIM)
    v = proj[..., OFF_V:OFF_CONV].reshape(bt, t, ATT_HEADS, ATT_HEAD_DIM)
    if attn_past is None:
        past = 0
        k_all, v_all = k, v
    else:
        past = attn_past[0].shape[1]
        k_all = jnp.concatenate([attn_past[0].astype(k.dtype), k], axis=1)
        v_all = jnp.concatenate([attn_past[1].astype(v.dtype), v], axis=1)
    q_pos = past + jnp.arange(t, dtype=jnp.int32)
    k_pos = jnp.arange(past + t, dtype=jnp.int32)
    lam = (jnp.exp(jnp.dot(prm['lq1'].astype(f32), prm['lk1'].astype(f32)))
           - jnp.exp(jnp.dot(prm['lq2'].astype(f32), prm['lk2'].astype(f32))) + lam_init)
    b_out = diff_attention(q, k_all, v_all, q_pos, k_pos, lam, lam_init, prm['dattn_norm'])
    c_out, new_buf = conformer_conv(proj[..., OFF_CONV:OFF_GMLP], conv_buf, prm['conv_w'], prm['conv_b'],
                                    prm['conv_ln_g'], prm['conv_ln_b'], prm['conv_w_pw'])
    d_out, gmlp_v = chunk_spatial_gating(proj[..., OFF_GMLP:IN_WIDTH], prm['gmlp_ln_g'], prm['gmlp_ln_b'],
                                         prm['gmlp_ws'], prm['gmlp_bs'])
    mix = jnp.concatenate([a_out, b_out, c_out.astype(x.dtype), d_out.astype(x.dtype)], axis=-1)
    x = x + mix @ prm['w_out']
    x = x + memory_cross_attention(rms_norm(x, prm['xattn_norm']), mem_k, mem_v, prm['xattn_wq'], prm['xattn_wo'])
    x = x + 0.5 * swiglu_ffn(rms_norm(x, prm['ffn2_norm']), prm['ffn2_w_gate'], prm['ffn2_w_up'], prm['ffn2_w_down'])
    return x, k, v, s_re, s_im, new_buf, gmlp_v


def setup_inputs(seed: int = 0) -> dict:
    key = jax.random.key(seed)
    ks = iter(jax.random.split(key, 80))
    f32 = jnp.float32
    L = DEPTH

    def nrm(shape, scale=1.0):
        return scale * jax.random.normal(next(ks), shape, f32)

    def gain(shape):
        return 1.0 + 0.05 * jax.random.normal(next(ks), shape, f32)

    n_idx = jnp.arange(SSM_STATE, dtype=f32)
    return {
        'x_prompt': nrm((BATCH, SEQ, D_MODEL)),
        'x_sample': nrm((DEC_BATCH, DEC_SEQ, D_MODEL)),
        'mem_prompt': nrm((BATCH, N_MEM, D_MODEL)),
        'cache_attn_k': nrm((L, DEC_BATCH, PAST_LEN, ATT_HEADS, ATT_HEAD_DIM)),
        'cache_attn_v': nrm((L, DEC_BATCH, PAST_LEN, ATT_HEADS, ATT_HEAD_DIM)),
        'state_ssm_re': nrm((L, DEC_BATCH, SSM_GROUPS, SSM_STATE), 0.5),
        'state_ssm_im': nrm((L, DEC_BATCH, SSM_GROUPS, SSM_STATE), 0.5),
        'state_conv': nrm((L, DEC_BATCH, CONV_K - 1, CONV_WIDTH), 0.5),
        'cache_mem_k': nrm((L, DEC_BATCH, N_MEM, X_HEADS, X_HEAD_DIM)),
        'cache_mem_v': nrm((L, DEC_BATCH, N_MEM, X_HEADS, X_HEAD_DIM)),
        'ffn1_norm': gain((L, D_MODEL)),
        'ffn1_w_gate': nrm((L, D_MODEL, D_FF), D_MODEL ** -0.5),
        'ffn1_w_up': nrm((L, D_MODEL, D_FF), D_MODEL ** -0.5),
        'ffn1_w_down': nrm((L, D_FF, D_MODEL), D_FF ** -0.5),
        'mix_norm': gain((L, D_MODEL)),
        'w_in': nrm((L, D_MODEL, IN_WIDTH), D_MODEL ** -0.5),
        'w_out': nrm((L, MIX_WIDTH, D_MODEL), MIX_WIDTH ** -0.5),
        'ssm_a_re': -0.5 + 0.01 * nrm((L, SSM_GROUPS, SSM_STATE)),
        'ssm_a_im': math.pi * n_idx + 0.01 * nrm((L, SSM_GROUPS, SSM_STATE)),
        'ssm_b_re': nrm((L, SSM_GROUPS, SSM_STATE, SSM_GROUP), (2 * SSM_GROUP) ** -0.5),
        'ssm_b_im': nrm((L, SSM_GROUPS, SSM_STATE, SSM_GROUP), (2 * SSM_GROUP) ** -0.5),
        'ssm_c_re': nrm((L, SSM_GROUPS, SSM_GROUP, SSM_STATE), (2 * SSM_STATE) ** -0.5),
        'ssm_c_im': nrm((L, SSM_GROUPS, SSM_GROUP, SSM_STATE), (2 * SSM_STATE) ** -0.5),
        'ssm_d': nrm((L, SSM_GROUPS, SSM_GROUP)),
        'ssm_log_dt': jax.random.uniform(next(ks), (L, SSM_GROUPS), f32, math.log(SSM_DT_MIN), math.log(SSM_DT_MAX)),
        'ssm_w_glu': nrm((L, SSM_WIDTH, SSM_WIDTH), SSM_WIDTH ** -0.5),
        'ssm_b_glu': nrm((L, SSM_WIDTH), 0.02),
        'dattn_lq1': nrm((L, ATT_HALF), 0.1),
        'dattn_lk1': nrm((L, ATT_HALF), 0.1),
        'dattn_lq2': nrm((L, ATT_HALF), 0.1),
        'dattn_lk2': nrm((L, ATT_HALF), 0.1),
        'dattn_norm': gain((L, ATT_HEAD_DIM)),
        'conv_w': nrm((L, CONV_K, CONV_WIDTH), CONV_K ** -0.5),
        'conv_b': nrm((L, CONV_WIDTH), 0.02),
        'conv_ln_g': gain((L, CONV_WIDTH)),
        'conv_ln_b': nrm((L, CONV_WIDTH), 0.02),
        'conv_w_pw': nrm((L, CONV_WIDTH, CONV_WIDTH), CONV_WIDTH ** -0.5),
        'gmlp_ln_g': gain((L, GMLP_WIDTH)),
        'gmlp_ln_b': nrm((L, GMLP_WIDTH), 0.02),
        'gmlp_ws': nrm((L, GMLP_HEADS, GMLP_CHUNK, GMLP_CHUNK), GMLP_CHUNK ** -0.5),
        'gmlp_bs': gain((L, GMLP_HEADS, GMLP_CHUNK)),
        'xattn_norm': gain((L, D_MODEL)),
        'mem_norm': gain((L, D_MODEL)),
        'xattn_wq': nrm((L, D_MODEL, X_WIDTH), D_MODEL ** -0.5),
        'xattn_wk': nrm((L, D_MODEL, X_WIDTH), D_MODEL ** -0.5),
        'xattn_wv': nrm((L, D_MODEL, X_WIDTH), D_MODEL ** -0.5),
        'xattn_wo': nrm((L, X_WIDTH, D_MODEL), X_WIDTH ** -0.5),
        'ffn2_norm': gain((L, D_MODEL)),
        'ffn2_w_gate': nrm((L, D_MODEL, D_FF), D_MODEL ** -0.5),
        'ffn2_w_up': nrm((L, D_MODEL, D_FF), D_MODEL ** -0.5),
        'ffn2_w_down': nrm((L, D_FF, D_MODEL), D_FF ** -0.5),
        'final_norm': gain((D_MODEL,)),
    }


def reference(x_prompt, x_sample, mem_prompt, cache_attn_k, cache_attn_v, state_ssm_re, state_ssm_im,
              state_conv, cache_mem_k, cache_mem_v,
              ffn1_norm, ffn1_w_gate, ffn1_w_up, ffn1_w_down, mix_norm, w_in, w_out,
              ssm_a_re, ssm_a_im, ssm_b_re, ssm_b_im, ssm_c_re, ssm_c_im, ssm_d, ssm_log_dt, ssm_w_glu, ssm_b_glu,
              dattn_lq1, dattn_lk1, dattn_lq2, dattn_lk2, dattn_norm,
              conv_w, conv_b, conv_ln_g, conv_ln_b, conv_w_pw,
              gmlp_ln_g, gmlp_ln_b, gmlp_ws, gmlp_bs,
              xattn_norm, mem_norm, xattn_wq, xattn_wk, xattn_wv, xattn_wo,
              ffn2_norm, ffn2_w_gate, ffn2_w_up, ffn2_w_down, final_norm):
    xp, xs = x_prompt, x_sample
    bp = x_prompt.shape[0]
    p_k, p_v, p_sre, p_sim, p_conv, p_mk, p_mv = [], [], [], [], [], [], []
    s_k, s_v, s_sre, s_sim, s_conv, s_gv = [], [], [], [], [], []
    for l in range(DEPTH):
        prm = dict(ffn1_norm=ffn1_norm[l], ffn1_w_gate=ffn1_w_gate[l], ffn1_w_up=ffn1_w_up[l], ffn1_w_down=ffn1_w_down[l],
                   mix_norm=mix_norm[l], w_in=w_in[l], w_out=w_out[l],
                   ssm_a_re=ssm_a_re[l], ssm_a_im=ssm_a_im[l], ssm_b_re=ssm_b_re[l], ssm_b_im=ssm_b_im[l],
                   ssm_c_re=ssm_c_re[l], ssm_c_im=ssm_c_im[l], ssm_d=ssm_d[l], ssm_log_dt=ssm_log_dt[l],
                   ssm_w_glu=ssm_w_glu[l], ssm_b_glu=ssm_b_glu[l],
                   lq1=dattn_lq1[l], lk1=dattn_lk1[l], lq2=dattn_lq2[l], lk2=dattn_lk2[l], dattn_norm=dattn_norm[l],
                   conv_w=conv_w[l], conv_b=conv_b[l], conv_ln_g=conv_ln_g[l], conv_ln_b=conv_ln_b[l], conv_w_pw=conv_w_pw[l],
                   gmlp_ln_g=gmlp_ln_g[l], gmlp_ln_b=gmlp_ln_b[l], gmlp_ws=gmlp_ws[l], gmlp_bs=gmlp_bs[l],
                   xattn_norm=xattn_norm[l], xattn_wq=xattn_wq[l], xattn_wo=xattn_wo[l],
                   ffn2_norm=ffn2_norm[l], ffn2_w_gate=ffn2_w_gate[l], ffn2_w_up=ffn2_w_up[l], ffn2_w_down=ffn2_w_down[l])
        lam_init = 0.8 - 0.6 * math.exp(-0.3 * l)
        mem_h = rms_norm(mem_prompt, mem_norm[l])
        mk = (mem_h @ xattn_wk[l]).reshape(bp, N_MEM, X_HEADS, X_HEAD_DIM)
        mv = (mem_h @ xattn_wv[l]).reshape(bp, N_MEM, X_HEADS, X_HEAD_DIM)
        zs = jnp.zeros((bp, SSM_GROUPS, SSM_STATE), xp.dtype)
        zb = jnp.zeros((bp, CONV_K - 1, CONV_WIDTH), xp.dtype)
        xp, kp_, vp_, srp, sip, cbp, _ = encoder_layer(xp, prm, lam_init, None, zs, zs, zb, mk, mv)
        p_k.append(kp_); p_v.append(vp_); p_sre.append(srp); p_sim.append(sip)
        p_conv.append(cbp); p_mk.append(mk); p_mv.append(mv)
        xs, ks_, vs_, srs, sis, cbs, gvs = encoder_layer(
            xs, prm, lam_init, (cache_attn_k[l], cache_attn_v[l]), state_ssm_re[l], state_ssm_im[l],
            state_conv[l], cache_mem_k[l], cache_mem_v[l])
        s_k.append(ks_); s_v.append(vs_); s_sre.append(srs); s_sim.append(sis)
        s_conv.append(cbs); s_gv.append(gvs)
    y_prompt = rms_norm(xp, final_norm)
    y_sample = rms_norm(xs, final_norm)
    return (y_prompt, y_sample,
            jnp.stack(p_k), jnp.stack(p_v), jnp.stack(p_sre), jnp.stack(p_sim), jnp.stack(p_conv),
            jnp.stack(p_mk), jnp.stack(p_mv),
            jnp.stack(s_k), jnp.stack(s_v), jnp.stack(s_sre), jnp.stack(s_sim), jnp.stack(s_conv),
            jnp.stack(s_gv))
```

```cpp
#include <hip/hip_runtime.h>
#include <cstdio>
#include <cstdint>

#define GAS __attribute__((address_space(1)))
#define LAS __attribute__((address_space(3)))
typedef unsigned short bf16;
typedef unsigned u32x4 __attribute__((ext_vector_type(4)));
typedef unsigned u32x2 __attribute__((ext_vector_type(2)));
typedef float f32x4 __attribute__((ext_vector_type(4)));
typedef float f32x2 __attribute__((ext_vector_type(2)));
typedef short bf16x8 __attribute__((ext_vector_type(8)));
typedef short s16x4 __attribute__((ext_vector_type(4)));
typedef GAS unsigned gu32;
#define DI __device__ __forceinline__

constexpr int DM = 1024, DEPTH = 4, DFF = 4096, INW = 2048, XW = 512;
constexpr int BP = 4, TP = 4096, BS = 32, TS = 64, PAST = 2048, NMEM = 256;
constexpr int NP = BP * TP, NS = BS * TS, MT = NP + NS;
constexpr float EPS = 1e-6f;
constexpr float LOG2E = 1.4426950408889634f;

constexpr size_t MiB = 1u << 20, KiB = 1024;
constexpr size_t WS_CTL = 0, CTL_ZERO_BYTES = 128 * KiB;
constexpr size_t WS_W = 1 * MiB, LW = 59 * MiB;
constexpr size_t W_GU1 = 0, W_D1 = 16 * MiB, W_IN = 25 * MiB, W_OUT = 29 * MiB, W_Q = 31 * MiB, W_O = 32 * MiB, W_GU2 = 33 * MiB, W_D2 = 49 * MiB, W_SMALL = 58 * MiB;
constexpr int ALD = DFF + 64;
constexpr size_t S_WGLU = 0, S_WPW = 128 * KiB, S_GMLPW = 256 * KiB, S_BBART = 384 * KiB, S_CMT = 448 * KiB, S_AB = 512 * KiB, S_A64 = 520 * KiB, S_A256 = 528 * KiB, S_LAM = 536 * KiB;
constexpr size_t WS_WKV = WS_W + 4 * LW;
constexpr size_t WS_MEMN = WS_WKV + 8 * MiB;
constexpr size_t WS_MK = WS_MEMN + 2 * MiB, WS_MV = WS_MK + 4 * MiB;
constexpr size_t WS_X = WS_MV + 4 * MiB;
constexpr size_t WS_XN = WS_X + 72 * MiB;
constexpr size_t WS_ACT = WS_XN + 36 * MiB;
constexpr size_t WS_P = WS_ACT, WS_MIX = WS_ACT + 72 * MiB, WS_Q = WS_ACT + 108 * MiB, WS_OX = WS_ACT + 126 * MiB;
constexpr size_t WS_SLAB = WS_ACT + 148 * MiB;
constexpr size_t WS_SSME = WS_SLAB + 64 * MiB;
constexpr size_t WS_SSP = WS_SSME + 2 * MiB;
constexpr size_t WS_RSTD = WS_SSP + 21 * MiB;
constexpr size_t WS_END = WS_RSTD + 2 * MiB;

constexpr int CW_TMO = 0, CW_BAR = 4096, CW_CNT = 16384, CW_CNTX = 20480;

constexpr size_t O_YP = 0, O_YS = O_YP + (size_t)NP * DM, O_PK = O_YS + (size_t)NS * DM, O_PV = O_PK + (size_t)DEPTH * NP * 256,
                 O_PSR = O_PV + (size_t)DEPTH * NP * 256, O_PSI = O_PSR + DEPTH * BP * 1024, O_PCV = O_PSI + DEPTH * BP * 1024,
                 O_PMK = O_PCV + DEPTH * BP * 30 * 256, O_PMV = O_PMK + (size_t)DEPTH * BP * NMEM * XW, O_SK = O_PMV + (size_t)DEPTH * BP * NMEM * XW,
                 O_SV = O_SK + (size_t)DEPTH * NS * 256, O_SSR = O_SV + (size_t)DEPTH * NS * 256, O_SSI = O_SSR + DEPTH * BS * 1024,
                 O_SCV = O_SSI + DEPTH * BS * 1024, O_SGV = O_SCV + DEPTH * BS * 30 * 256, O_END = O_SGV + (size_t)DEPTH * NS * 256;

enum { I_XP = 0, I_XS, I_MEM, I_CK, I_CV, I_SRE, I_SIM, I_SCONV, I_CMK, I_CMV, I_F1N, I_F1G, I_F1U, I_F1D, I_MIXN, I_WIN, I_WOUT,
       I_AR, I_AI, I_BR, I_BI, I_CR, I_CI, I_SD, I_LDT, I_WGLU, I_BGLU, I_LQ1, I_LK1, I_LQ2, I_LK2, I_DNORM,
       I_CW, I_CB, I_CLG, I_CLB, I_CPW, I_GLG, I_GLB, I_GWS, I_GBS, I_XN, I_MEMNORM, I_XWQ, I_XWK, I_XWV, I_XWO,
       I_F2N, I_F2G, I_F2U, I_F2D, I_FINAL, N_IN };

constexpr int LDS_BYTES = 163840, LDS_MAIN = 159744, LDSCTL_OFF = LDS_MAIN, LDS_RS = 131072;
constexpr int NWAVES = 8, NTHR = 512;

#define RLX_AGENT __ATOMIC_RELAXED, __HIP_MEMORY_SCOPE_AGENT
#define LDS_WAIT() asm volatile("s_waitcnt lgkmcnt(0)" ::: "memory")
#define VM_WAIT() asm volatile("s_waitcnt vmcnt(0)" ::: "memory")
typedef __bf16 hwbf16x2 __attribute__((ext_vector_type(2)));
DI unsigned pk2(float lo, float hi) { const f32x2 v = {lo, hi}; return __builtin_bit_cast(unsigned, __builtin_convertvector(v, hwbf16x2)); }
DI unsigned f2bf(float f) { return pk2(f, f) & 0xffffu; }
DI float bf2f(unsigned short b) { return __builtin_bit_cast(float, (unsigned)b << 16); }
DI float bflo(unsigned w) { return __builtin_bit_cast(float, w << 16); }
DI float bfhi(unsigned w) { return __builtin_bit_cast(float, w & 0xffff0000u); }
DI float fast_exp2(float x) { return __builtin_amdgcn_exp2f(x); }
DI float fast_rcp(float x) { return __builtin_amdgcn_rcpf(x); }
DI float sigmoidf_(float x) { return fast_rcp(1.f + fast_exp2(-LOG2E * x)); }
DI float siluf_(float x) { return x * sigmoidf_(x); }
DI float gelu_tanh(float x) { const float z = 0.7978845608028654f * (x + 0.044715f * x * x * x); return x * fast_rcp(1.f + fast_exp2(-2.f * LOG2E * z)); }
template <int N> DI void wave_sum_n(float (&v)[N]) {
#pragma unroll
    for (int o = 1; o < 64; o <<= 1) {
        float t[N];
#pragma unroll
        for (int i = 0; i < N; ++i) t[i] = __shfl_xor(v[i], o);
#pragma unroll
        for (int i = 0; i < N; ++i) v[i] += t[i]; }
}
DI float wave_sum(float v) {
#pragma unroll
    for (int o = 1; o < 64; o <<= 1) v += __shfl_xor(v, o);
    return v;
}

#define XB_TMO      128
#define XB_XCNT(j)  (256  + 64 * (j))
#define XB_XSUB(j)  (1280 + 64 * (j))
#define XB_XGEN(j)  (2304 + 64 * (j))
#define XB_TOP      3328
#define XB_TOPGEN   3392
#define XCD_BAR_WORDS 3456
#define XB_SPIN_CAP (1u << 18)
DI unsigned xb_ld(unsigned* p)              { return __hip_atomic_load(p, __ATOMIC_RELAXED, __HIP_MEMORY_SCOPE_AGENT); }
DI unsigned xb_add(unsigned* p, unsigned v) { return __hip_atomic_fetch_add(p, v, __ATOMIC_RELAXED, __HIP_MEMORY_SCOPE_AGENT); }
DI unsigned xb_xcc_id() { return (unsigned)__builtin_amdgcn_s_getreg((3 << 11) | 20) & 0xFu; }
#define XB_SPIN(cond, bar) do { unsigned _sp = 0; while (cond) { __builtin_amdgcn_s_sleep(1); \
    if ((++_sp & 255u) == 0u) { if (xb_ld(&(bar)[XB_TMO])) break; if (_sp > XB_SPIN_CAP) { atomicAdd(&(bar)[XB_TMO], 1u); break; } } } } while (0)
struct XcdBarrier { unsigned* bar; unsigned x; volatile LAS unsigned* st; };
DI XcdBarrier xcd_barrier_post(unsigned* bar, volatile LAS unsigned* st) {
    XcdBarrier b; b.bar = bar; b.x = xb_xcc_id(); b.st = st;
    if (threadIdx.x == 0) (void)xb_add(&bar[XB_XCNT(b.x)], 1u);
    return b;
}
DI void xcd_barrier_complete(unsigned* bar, unsigned x, unsigned& nloc, unsigned& nx, unsigned& rank) {
    const unsigned G = gridDim.x * gridDim.y * gridDim.z;
    unsigned sum, cnt, mine, rk, sp = 0u;
    for (;;) {
        sum = 0u; cnt = 0u; mine = 0u; rk = 0u;
#pragma unroll
        for (unsigned j = 0; j < 16; ++j) { const unsigned c = xb_ld(&bar[XB_XCNT(j)]); sum += c; cnt += (c > 0u) ? 1u : 0u; mine = (j == x) ? c : mine; rk += (j < x && c > 0u) ? 1u : 0u; }
        if (sum == G) break;
        __builtin_amdgcn_s_sleep(1);
        if ((++sp & 255u) == 0u) { if (xb_ld(&bar[XB_TMO])) break; if (sp > XB_SPIN_CAP) { atomicAdd(&bar[XB_TMO], 1u); break; } }
    }
    nloc = mine > 0u ? mine : 1u; nx = cnt > 0u ? cnt : 1u; rank = rk;
}
DI void xcd_barrier(const XcdBarrier& b) {
    asm volatile("s_waitcnt vmcnt(0)" ::: "memory");
    __syncthreads();
    if (threadIdx.x == 0) {
        unsigned* bar = b.bar;
        __builtin_amdgcn_s_waitcnt(0);
        unsigned nloc = b.st[0], nx = b.st[1];
        if (nloc == 0u) { unsigned rk = 0u; xcd_barrier_complete(bar, b.x, nloc, nx, rk); b.st[0] = nloc; b.st[1] = nx; b.st[2] = rk; }
        const unsigned old = xb_add(&bar[XB_XSUB(b.x)], 1u);
        const unsigned gen = old / nloc;
        if (old + 1u == (gen + 1u) * nloc) {
            __builtin_amdgcn_fence(__ATOMIC_RELEASE, "agent");
            asm volatile("s_waitcnt vmcnt(0)" ::: "memory");
            const unsigned og = xb_add(&bar[XB_TOP], 1u);
            const unsigned tg = og / nx;
            if (og + 1u == (tg + 1u) * nx) xb_add(&bar[XB_TOPGEN], 1u);
            else XB_SPIN(xb_ld(&bar[XB_TOPGEN]) == tg, bar);
            __builtin_amdgcn_fence(__ATOMIC_ACQUIRE, "agent");
            xb_add(&bar[XB_XGEN(b.x)], 1u);
            asm volatile("s_waitcnt vmcnt(0)" ::: "memory");
        } else {
            XB_SPIN(xb_ld(&bar[XB_XGEN(b.x)]) == gen, bar);
            __builtin_amdgcn_fence(__ATOMIC_ACQUIRE, "agent");
            asm volatile("s_waitcnt vmcnt(0)" ::: "memory");
        }
    }
    __syncthreads();
}

namespace pg8 {
constexpr int BM = 256, BK = 64, HALF = 128, HTB = HALF * BK * 2, STAGE_BYTES = 8 * HTB;
__host__ __device__ __forceinline__ int lds_byte(int r, int c) { const int st = (r >> 4) * 2 + (c >> 5), rr = r & 15, cc = c & 31, ob = rr * 64 + cc * 2; return st * 1024 + (ob ^ (((ob >> 9) & 1) << 5)); }
__host__ __device__ __forceinline__ void stage_rc(int b, int& R, int& C) { const int st = b / 1024, sb = b % 1024, swz = sb ^ (((sb >> 9) & 1) << 5); R = (st >> 1) * 16 + swz / 64; C = (st & 1) * 32 + (swz % 64) / 2; }
__host__ __device__ __forceinline__ int perm32(int rho) { const int n = rho >> 4, i = rho & 15; return 8 * (i >> 2) + 4 * n + (i & 3); }

struct Unit { const char* a; const char* b; int pm, pn, nt, kind, aux, ui; };

DI void tile_of(int L, int nM, int nN, int& pm, int& pn) {
    const int nwg = nM * nN; int wgid = L; { const int q = nwg / 8, r = nwg % 8, xcd = wgid % 8, off = wgid / 8; wgid = (xcd < r ? xcd * (q + 1) : r * (q + 1) + (xcd - r) * q) + off; }
    const int nig = 8 * nN, gid = wgid / nig, fm = gid * 8, gsz = (nM - fm) < 8 ? (nM - fm) : 8;
    pm = fm + ((wgid % nig) % gsz); pn = (wgid % nig) / gsz;
}
struct Sched {
    const char *A, *B; int lda, ldb, nM, nN, nt, G, c;
    const char *XA, *XB; int xM0, xnM, xnN, xS, xnt;
    int pn0;
    DI bool next(int i, Unit& u) const {
        int L = i * G + c; const int nwg = nM * nN;
        if (L < nwg) { tile_of(L, nM, nN, u.pm, u.pn); u.pn += pn0; u.a = A + (size_t)u.pm * 256 * lda * 2; u.b = B + (size_t)u.pn * 256 * ldb * 2; u.nt = nt; u.kind = 0; u.aux = 0; u.ui = i; return true; }
        L -= nwg;
        if (L < xnM * xnN * xS) { const int s = L % xS, t = L / xS; const int tm = t / xnN, tn = t % xnN; u.pm = xM0 + tm; u.pn = tn; const size_t k0 = (size_t)s * xnt * 64;
            u.a = XA + ((size_t)tm * 256 * lda + k0) * 2; u.b = XB + ((size_t)tn * 256 * ldb + k0) * 2; u.nt = xnt; u.kind = 1; u.aux = s; u.ui = i; return true; }
        return false;
    }
};

template <class Epi, bool ALIGN_EPI>
DI void gemm_phase(LAS unsigned char* lds, const Sched& S, const Epi& E, int tid) {
    const int wid = __builtin_amdgcn_readfirstlane(tid >> 6), lane = tid & 63, wr = wid >> 2, wc = wid & 3, fr = lane & 15, fq = lane >> 4;
    const int lda = S.lda, ldb = S.ldb;
    unsigned voffA[2], voffB[2];
#pragma unroll
    for (int i = 0; i < 2; ++i) { int R, C; stage_rc(tid * 16 + i * 8192, R, C); const int Rb = (R & ~31) + perm32(R & 31);
        voffA[i] = (unsigned)(R * lda + C) * 2u; voffB[i] = (unsigned)(Rb * ldb + C) * 2u; }
    const size_t kstep = (size_t)(BK * 2);
    const size_t hstepA = (size_t)HALF * lda * 2, hstepB = (size_t)HALF * ldb * 2;
    const unsigned ldsw = (unsigned)wid * 1024u;
    const int aoff = lds_byte(wr * 64 + fr, fq * 8), boff = lds_byte(wc * 32 + fr, fq * 8);
#define PG8_SA(b, h) (((b) * 2 + (h)) * HTB)
#define PG8_SB(b, h) ((4 + (b) * 2 + (h)) * HTB)
#define PG8_STAGE(bufoff, gbase, voff) do { _Pragma("unroll") for (int _i = 0; _i < 2; ++_i) \
        __builtin_amdgcn_global_load_lds((const unsigned*)((const char*)(gbase) + (voff)[_i]), (LAS unsigned*)(lds + (bufoff) + ldsw + _i * 8192), 16, 0, 0); } while (0)
#define PG8_LDA(dst, b, h) do { _Pragma("unroll") for (int m = 0; m < 4; ++m) _Pragma("unroll") for (int k = 0; k < 2; ++k) dst[m][k] = *(const LAS bf16x8*)(lds + PG8_SA(b, h) + aoff + m * 2048 + k * 1024); } while (0)
#define PG8_LDB(dst, b, h) do { _Pragma("unroll") for (int n = 0; n < 2; ++n) _Pragma("unroll") for (int k = 0; k < 2; ++k) dst[n][k] = *(const LAS bf16x8*)(lds + PG8_SB(b, h) + boff + n * 2048 + k * 1024); } while (0)
#define PG8_MMA(ai, bj, At, Bt) do { __builtin_amdgcn_s_setprio(1); _Pragma("unroll") for (int m = 0; m < 4; ++m) _Pragma("unroll") for (int n = 0; n < 2; ++n) _Pragma("unroll") for (int k = 0; k < 2; ++k) \
        acc[ai][bj][m][n] = __builtin_amdgcn_mfma_f32_16x16x32_bf16(Bt[n][k], At[m][k], acc[ai][bj][m][n], 0, 0, 0); __builtin_amdgcn_s_setprio(0); } while (0)
#define PG8_WAIT_V(n) asm volatile("s_waitcnt vmcnt(" #n ")" ::: "memory")
#define PG8_WAIT_L(n) asm volatile("s_waitcnt lgkmcnt(" #n ")" ::: "memory")
#define PG8_BAR __builtin_amdgcn_s_barrier()
#define PG8_SCHED __builtin_amdgcn_sched_barrier(0)
    Unit cur, nxt; int ui = 0;
    if (!S.next(0, cur)) return;
    f32x4 acc[2][2][4][2];
#pragma unroll
    for (int a = 0; a < 2; ++a)
#pragma unroll
        for (int b = 0; b < 2; ++b)
#pragma unroll
            for (int m = 0; m < 4; ++m)
#pragma unroll
                for (int n = 0; n < 2; ++n) acc[a][b][m][n] = (f32x4){0.f, 0.f, 0.f, 0.f};
    bf16x8 At[4][2], B0[2][2], B1[2][2];
    const char* cA = cur.a; const char* cB = cur.b;
    PG8_STAGE(PG8_SB(0, 0), cB, voffB); PG8_STAGE(PG8_SB(0, 1), cB + hstepB, voffB); PG8_STAGE(PG8_SA(0, 0), cA, voffA); PG8_STAGE(PG8_SA(0, 1), cA + hstepA, voffA);
    if (wr == 1) PG8_BAR;
    PG8_WAIT_V(2); PG8_BAR;
    PG8_STAGE(PG8_SB(1, 0), cB + kstep, voffB); PG8_STAGE(PG8_SA(1, 0), cA + kstep, voffA); PG8_STAGE(PG8_SB(1, 1), cB + hstepB + kstep, voffB);
    PG8_WAIT_V(6); PG8_BAR;
    for (;;) {
        const bool has_next = S.next(ui + 1, nxt);
        const char* nA = has_next ? nxt.a : cA; const char* nB = has_next ? nxt.b : cB;
        const int nt = cur.nt;
        for (int t = 0; t < nt; t += 2) {
            const bool last = (t == nt - 2);
            const char* a1 = cA + (size_t)(t + 1) * kstep;
            const char* a2 = last ? nA : cA + (size_t)(t + 2) * kstep; const char* b2 = last ? nB : cB + (size_t)(t + 2) * kstep;
            const char* a3 = a2 + kstep; const char* b3 = b2 + kstep;
            PG8_LDB(B0, 0, 0); PG8_LDB(B1, 0, 1); PG8_SCHED; PG8_LDA(At, 0, 0); PG8_STAGE(PG8_SA(1, 1), a1 + hstepA, voffA);
            PG8_WAIT_V(8); PG8_WAIT_L(0); PG8_BAR; PG8_MMA(0, 0, At, B0); PG8_MMA(0, 1, At, B1); PG8_BAR; PG8_SCHED;
            PG8_LDA(At, 0, 1); PG8_STAGE(PG8_SB(0, 0), b2, voffB); PG8_STAGE(PG8_SB(0, 1), b2 + hstepB, voffB); PG8_STAGE(PG8_SA(0, 0), a2, voffA);
            PG8_WAIT_V(8); PG8_WAIT_L(0); PG8_BAR; PG8_MMA(1, 0, At, B0); PG8_MMA(1, 1, At, B1); PG8_BAR; PG8_SCHED;
            PG8_LDB(B0, 1, 0); PG8_LDB(B1, 1, 1); PG8_SCHED; PG8_LDA(At, 1, 0); PG8_STAGE(PG8_SA(0, 1), a2 + hstepA, voffA);
            PG8_WAIT_V(8); PG8_WAIT_L(0); PG8_BAR; PG8_MMA(0, 0, At, B0); PG8_MMA(0, 1, At, B1); PG8_BAR; PG8_SCHED;
            PG8_LDA(At, 1, 1); PG8_STAGE(PG8_SB(1, 0), b3, voffB); PG8_STAGE(PG8_SB(1, 1), b3 + hstepB, voffB); PG8_STAGE(PG8_SA(1, 0), a3, voffA);
            PG8_WAIT_V(8); PG8_WAIT_L(0); PG8_BAR; PG8_MMA(1, 0, At, B0); PG8_MMA(1, 1, At, B1); PG8_BAR; PG8_SCHED;
        }
        if constexpr (ALIGN_EPI) { if (wr == 0) PG8_BAR; }
        E(acc, cur, wr, wc, fr, fq);
        if (!has_next) break;
#pragma unroll
        for (int a = 0; a < 2; ++a)
#pragma unroll
            for (int b = 0; b < 2; ++b)
#pragma unroll
                for (int m = 0; m < 4; ++m)
#pragma unroll
                    for (int n = 0; n < 2; ++n) acc[a][b][m][n] = (f32x4){0.f, 0.f, 0.f, 0.f};
        cur = nxt; cA = nA; cB = nB; ++ui;
        if constexpr (ALIGN_EPI) { if (wr == 1) PG8_BAR; }
    }
    PG8_WAIT_V(0);
    if constexpr (!ALIGN_EPI) { if (wr == 0) PG8_BAR; }
    PG8_BAR;
#undef PG8_SA
#undef PG8_SB
#undef PG8_STAGE
#undef PG8_LDA
#undef PG8_LDB
#undef PG8_MMA
#undef PG8_WAIT_V
#undef PG8_WAIT_L
#undef PG8_BAR
#undef PG8_SCHED
}
typedef f32x4 Acc[2][2][4][2];
}
struct Args { const float* in[N_IN]; float* out; unsigned char* ws; int ph_lo, ph_hi; };
struct Frame {
    LAS unsigned char* lds;
    volatile LAS unsigned* MISC;
    gu32* ctl;
    int tid, lane, wave, G, bid;
};

DI u32x4 pack8(f32x4 a, f32x4 b) { u32x4 w; w.x = pk2(a[0], a[1]); w.y = pk2(a[2], a[3]); w.z = pk2(b[0], b[1]); w.w = pk2(b[2], b[3]); return w; }

struct EpiSwiGLU {
    bf16* ACT; const LAS float* rs;
    DI void operator()(const pg8::Acc& acc, const pg8::Unit& u, int wr, int wc, int fr, int fq) const {
        const int row0 = u.pm * 256 + wr * 64 + fr, col = u.pn * 128 + wc * 32 + 8 * fq;
        const LAS float* rt = rs + u.ui * 256 + wr * 64 + fr;
#pragma unroll
        for (int ai = 0; ai < 2; ++ai)
#pragma unroll
            for (int m = 0; m < 4; ++m) {
                const float r = rt[ai * 128 + m * 16], rl = -LOG2E * r, r2 = r * r;
                const f32x4 g0 = acc[ai][0][m][0], g1 = acc[ai][0][m][1];
                f32x4 e0 = g0 * rl, e1 = g1 * rl;
#pragma unroll
                for (int e = 0; e < 4; ++e) { e0[e] = fast_exp2(e0[e]); e1[e] = fast_exp2(e1[e]); }
                e0 = e0 + 1.f; e1 = e1 + 1.f;
#pragma unroll
                for (int e = 0; e < 4; ++e) { e0[e] = fast_rcp(e0[e]); e1[e] = fast_rcp(e1[e]); }
                const f32x4 r0 = (g0 * acc[ai][1][m][0]) * (e0 * r2), r1 = (g1 * acc[ai][1][m][1]) * (e1 * r2);
                *(u32x4*)(ACT + (size_t)(row0 + ai * 128 + m * 16) * ALD + col) = pack8(r0, r1);
            }
    }
};
struct EpiResid {
    unsigned char* ws; float scale; int site;
    DI void operator()(const pg8::Acc& acc, const pg8::Unit& u, int wr, int wc, int fr, int fq) const {
        const int row0 = u.pm * 256 + wr * 64 + fr, col0 = u.pn * 256 + wc * 32 + 8 * fq;
        if (u.kind == 0) {
            float* X = (float*)(ws + WS_X); float* SSP = (float*)(ws + WS_SSP) + (size_t)site * MT * 16;
#pragma unroll
            for (int ai = 0; ai < 2; ++ai) {
                bf16* XH = (bf16*)X;
                u32x4 xv[4][2];
#pragma unroll
                for (int m = 0; m < 4; ++m)
#pragma unroll
                    for (int bj = 0; bj < 2; ++bj) xv[m][bj] = *(const u32x4*)(XH + (size_t)(row0 + ai * 128 + m * 16) * DM + col0 + bj * 128);
#pragma unroll
                for (int m = 0; m < 4; ++m) { const int row = row0 + ai * 128 + m * 16; float ssq = 0.f;
#pragma unroll
                    for (int bj = 0; bj < 2; ++bj) { const u32x4 x = xv[m][bj];
                        const f32x4 xa = (f32x4){bflo(x.x), bfhi(x.x), bflo(x.y), bfhi(x.y)} + acc[ai][bj][m][0] * scale, xb = (f32x4){bflo(x.z), bfhi(x.z), bflo(x.w), bfhi(x.w)} + acc[ai][bj][m][1] * scale;
                        *(u32x4*)(XH + (size_t)row * DM + col0 + bj * 128) = pack8(xa, xb);
                        ssq += ((xa[0] * xa[0] + xa[1] * xa[1]) + (xa[2] * xa[2] + xa[3] * xa[3])) + ((xb[0] * xb[0] + xb[1] * xb[1]) + (xb[2] * xb[2] + xb[3] * xb[3])); }
                    ssq += __shfl_xor(ssq, 16); ssq += __shfl_xor(ssq, 32);
                    if (fq == 0) SSP[(size_t)row * 16 + u.pn * 4 + wc] = ssq; }
            }
        } else {
            bf16* sb = (bf16*)(ws + WS_SLAB) + (size_t)u.aux * NS * DM;
#pragma unroll
            for (int ai = 0; ai < 2; ++ai)
#pragma unroll
                for (int m = 0; m < 4; ++m) { bf16* rp = sb + (size_t)(row0 - NP + ai * 128 + m * 16) * DM + col0;
#pragma unroll
                    for (int bj = 0; bj < 2; ++bj) *(u32x4*)(rp + bj * 128) = pack8(acc[ai][bj][m][0], acc[ai][bj][m][1]); }
        }
    }
};
constexpr float QSCALE = 0.17677669529663687f * LOG2E;
struct EpiWin {
    bf16* P; float *okp, *ovp, *oks, *ovs; float *omk, *omv; bf16 *MK, *MV; const LAS float* rs;
    DI void operator()(const pg8::Acc& acc, const pg8::Unit& u, int wr, int wc, int fr, int fq) const {
        const int row0 = u.pm * 256 + wr * 64 + fr, cl = wc * 32 + 8 * fq;
        if (u.kind == 0) {
            const int pn = u.pn;
#pragma unroll
            for (int ai = 0; ai < 2; ++ai)
#pragma unroll
                for (int m = 0; m < 4; ++m) { const int row = row0 + ai * 128 + m * 16; const float r = rs[u.ui * 256 + wr * 64 + fr + ai * 128 + m * 16] * (pn == 1 ? QSCALE : 1.f);
#pragma unroll
                    for (int bj = 0; bj < 2; ++bj) { f32x4 a = acc[ai][bj][m][0] * r, b = acc[ai][bj][m][1] * r;
                        if (pn >= 6) {
#pragma unroll
                            for (int e = 0; e < 4; ++e) { a[e] = gelu_tanh(a[e]); b[e] = gelu_tanh(b[e]); } }
                        if (pn == 2 || pn == 3) { float* o = (pn == 2) ? (row < NP ? okp + (size_t)row * 256 : oks + (size_t)(row - NP) * 256) : (row < NP ? ovp + (size_t)row * 256 : ovs + (size_t)(row - NP) * 256);
                            f32x4* q = (f32x4*)(o + cl + bj * 128); q[0] = a; q[1] = b; }
                        *(u32x4*)(P + (size_t)row * INW + pn * 256 + cl + bj * 128) = pack8(a, b); } }
        } else {
            const bool isv = u.pn >= 2; float* o = isv ? omv : omk; bf16* ob = isv ? MV : MK; const int cb = (u.pn & 1) * 256 + cl;
#pragma unroll
            for (int ai = 0; ai < 2; ++ai)
#pragma unroll
                for (int m = 0; m < 4; ++m) { const int row = row0 + ai * 128 + m * 16;
#pragma unroll
                    for (int bj = 0; bj < 2; ++bj) { const f32x4 a = acc[ai][bj][m][0], b = acc[ai][bj][m][1];
                        f32x4* q = (f32x4*)(o + (size_t)row * XW + cb + bj * 128); q[0] = a; q[1] = b;
                        *(u32x4*)(ob + (size_t)row * XW + cb + bj * 128) = pack8(a, b); } }
        }
    }
};
constexpr float XQSCALE = 0.08838834764831845f * LOG2E;
struct EpiQ {
    bf16* Q; const LAS float* rs;
    DI void operator()(const pg8::Acc& acc, const pg8::Unit& u, int wr, int wc, int fr, int fq) const {
        const int row0 = u.pm * 256 + wr * 64 + fr, col0 = u.pn * 256 + wc * 32 + 8 * fq;
#pragma unroll
        for (int ai = 0; ai < 2; ++ai)
#pragma unroll
            for (int m = 0; m < 4; ++m) { const float r = rs[u.ui * 256 + wr * 64 + fr + ai * 128 + m * 16] * XQSCALE;
#pragma unroll
                for (int bj = 0; bj < 2; ++bj)
                    *(u32x4*)(Q + (size_t)(row0 + ai * 128 + m * 16) * XW + col0 + bj * 128) = pack8(acc[ai][bj][m][0] * r, acc[ai][bj][m][1] * r); }
    }
};

struct CvtDesc { const float* src; const float* gain; bf16* dst; int N, ldt, k0; };
DI void cvt_load(const CvtDesc& d, int lane, f32x2 (&wv)[32]) {
#pragma unroll
    for (int i = 0; i < 32; ++i) wv[i] = __builtin_nontemporal_load((const f32x2*)(d.src + (size_t)i * d.N + 2 * lane));
}
DI void cvt_store(const CvtDesc& d, int lane, f32x2 (&wv)[32], LAS float* scr) {
    if (d.gain) {
#pragma unroll
        for (int i = 0; i < 32; ++i) wv[i] = wv[i] * d.gain[d.k0 + i]; }
#pragma unroll
    for (int i = 0; i < 32; ++i) *(LAS f32x2*)(scr + i * 130 + 2 * lane) = wv[i];
    LDS_WAIT(); asm volatile("" ::: "memory");
    const int c = lane & 3;
#pragma unroll
    for (int j = 0; j < 8; ++j) { const int n = (lane >> 2) + 16 * j; const LAS float* s = scr + (8 * c) * 130 + n;
        u32x4 o; o.x = pk2(s[0 * 130], s[1 * 130]); o.y = pk2(s[2 * 130], s[3 * 130]); o.z = pk2(s[4 * 130], s[5 * 130]); o.w = pk2(s[6 * 130], s[7 * 130]);
        *(GAS u32x4*)(d.dst + (size_t)n * d.ldt + 8 * c) = o; }
    LDS_WAIT(); asm volatile("" ::: "memory");
}
DI CvtDesc cvt_mk(const float* W, int K, int N, const float* gain, bf16* WT, int row_off, int map, int item, int ldt) {
    const int nnb = N / 128, nb = item % nnb, kb = item / nnb, n0 = 128 * nb, k0 = 32 * kb;
    int drow0 = row_off + n0;
    if (map) drow0 = row_off + 256 * (n0 >> 7) + (map == 2 ? 128 : 0);
    const int ld = ldt ? ldt : K;
    CvtDesc d; d.src = W + (size_t)k0 * N + n0; d.gain = gain; d.dst = WT + (size_t)drow0 * ld + k0; d.N = N; d.ldt = ld; d.k0 = k0; return d;
}
struct BigDesc { const float* src; const float* gain; bf16* dst; int N, ldt, map; };
constexpr int BT_FF = (DM / 64) * (DFF / 512), BT_DN = (DFF / 64) * (DM / 512), BT_IN = (DM / 64) * (INW / 512), BT_OUT = (DM / 64) * (DM / 512), BT_Q = (DM / 64) * (XW / 512), BT_O = (XW / 64) * (DM / 512);
constexpr int BT_LAYER = 4 * BT_FF + 2 * BT_DN + BT_IN + BT_OUT + 3 * BT_Q + BT_O, BT_EARLY = 2 * BT_FF + BT_DN + BT_IN + 2 * BT_Q;
DI BigDesc big_mk(const float* W, int K, int N, const float* gain, bf16* WT, int row_off, int map, int item, int ldt, int& n0) {
    const int nnb = N / 512, nb = item % nnb, kb = item / nnb, k0 = 64 * kb; n0 = 512 * nb;
    const int ld = ldt ? ldt : K;
    BigDesc d; d.src = W + (size_t)k0 * N + n0; d.gain = gain ? gain + k0 : nullptr; d.dst = WT + (size_t)row_off * ld + k0; d.N = N; d.ldt = ld; d.map = map; return d;
}
DI BigDesc big_desc(const Args& a, int it, int& n0) {
    const int l = it / BT_LAYER; int r = it % BT_LAYER;
    unsigned char* ws = a.ws; unsigned char* wl = ws + WS_W + (size_t)l * LW;
    const size_t oFF = (size_t)l * DM * DFF, oIN = (size_t)l * DM * INW, oDD = (size_t)l * DM * DM, oXQ = (size_t)l * DM * XW;
    if (r < BT_FF) return big_mk(a.in[I_F1G] + oFF, DM, DFF, a.in[I_F1N] + l * DM, (bf16*)(wl + W_GU1), 0, 1, r, 0, n0); r -= BT_FF;
    if (r < BT_FF) return big_mk(a.in[I_F1U] + oFF, DM, DFF, a.in[I_F1N] + l * DM, (bf16*)(wl + W_GU1), 0, 2, r, 0, n0); r -= BT_FF;
    if (r < BT_DN) return big_mk(a.in[I_F1D] + oFF, DFF, DM, nullptr, (bf16*)(wl + W_D1), 0, 0, r, ALD, n0); r -= BT_DN;
    if (r < BT_IN) return big_mk(a.in[I_WIN] + oIN, DM, INW, a.in[I_MIXN] + l * DM, (bf16*)(wl + W_IN), 0, 0, r, 0, n0); r -= BT_IN;
    if (r < BT_Q) return big_mk(a.in[I_XWK] + oXQ, DM, XW, a.in[I_MEMNORM] + l * DM, (bf16*)(ws + WS_WKV), l * 1024, 0, r, 0, n0); r -= BT_Q;
    if (r < BT_Q) return big_mk(a.in[I_XWV] + oXQ, DM, XW, a.in[I_MEMNORM] + l * DM, (bf16*)(ws + WS_WKV), l * 1024 + 512, 0, r, 0, n0); r -= BT_Q;
    if (r < BT_FF) return big_mk(a.in[I_F2G] + oFF, DM, DFF, a.in[I_F2N] + l * DM, (bf16*)(wl + W_GU2), 0, 1, r, 0, n0); r -= BT_FF;
    if (r < BT_FF) return big_mk(a.in[I_F2U] + oFF, DM, DFF, a.in[I_F2N] + l * DM, (bf16*)(wl + W_GU2), 0, 2, r, 0, n0); r -= BT_FF;
    if (r < BT_DN) return big_mk(a.in[I_F2D] + oFF, DFF, DM, nullptr, (bf16*)(wl + W_D2), 0, 0, r, ALD, n0); r -= BT_DN;
    if (r < BT_OUT) return big_mk(a.in[I_WOUT] + oDD, DM, DM, nullptr, (bf16*)(wl + W_OUT), 0, 0, r, 0, n0); r -= BT_OUT;
    if (r < BT_Q) return big_mk(a.in[I_XWQ] + oXQ, DM, XW, a.in[I_XN] + l * DM, (bf16*)(wl + W_Q), 0, 0, r, 0, n0); r -= BT_Q;
    return big_mk(a.in[I_XWO] + oXQ, XW, DM, nullptr, (bf16*)(wl + W_O), 0, 0, r, 0, n0);
}
DI void big_load(const BigDesc& d, int tid, f32x4 (&w)[16]) {
#pragma unroll
    for (int i = 0; i < 16; ++i) { const int idx = tid + i * NTHR, row = idx >> 7, c4 = idx & 127; w[i] = __builtin_nontemporal_load((const f32x4*)(d.src + (size_t)row * d.N + 4 * c4)); }
}
DI void big_to_lds(const BigDesc& d, int tid, const f32x4 (&w)[16], LAS float* T) {
#pragma unroll
    for (int i = 0; i < 16; ++i) { const int idx = tid + i * NTHR, row = idx >> 7, c4 = idx & 127; const float g = d.gain ? d.gain[row] : 1.f;
        LAS float* p = T + row * 513 + 4 * c4; p[0] = w[i][0] * g; p[1] = w[i][1] * g; p[2] = w[i][2] * g; p[3] = w[i][3] * g; }
}
DI void big_store(const BigDesc& d, int n0, int tid, const LAS float* T) {
#pragma unroll
    for (int j = 0; j < 8; ++j) { const int cidx = tid + j * NTHR, n = cidx >> 3, c = cidx & 7; const LAS float* s = T + (8 * c) * 513 + n;
        u32x4 o; o.x = pk2(s[0 * 513], s[1 * 513]); o.y = pk2(s[2 * 513], s[3 * 513]); o.z = pk2(s[4 * 513], s[5 * 513]); o.w = pk2(s[6 * 513], s[7 * 513]);
        const int ng = n0 + n; const int drow = d.map ? 256 * (ng >> 7) + (ng & 127) + (d.map == 2 ? 128 : 0) : ng;
        *(GAS u32x4*)(d.dst + (size_t)drow * d.ldt + 8 * c) = o; }
}
DI void prologue_weights_big(const Args& a, const Frame& F) {
    LAS float* T = (LAS float*)F.lds;
    constexpr int NIT = BT_EARLY;
    int it = F.bid; if (it >= NIT) return;
    int n0 = 0, n1 = 0;
    f32x4 w[16];
    BigDesc d = big_desc(a, it, n0); big_load(d, F.tid, w);
    for (;;) {
        big_to_lds(d, F.tid, w, T);
        __syncthreads();
        const bool more = it + F.G < NIT; BigDesc dn = d;
        if (more) { dn = big_desc(a, it + F.G, n1); big_load(dn, F.tid, w); }
        big_store(d, n0, F.tid, T);
        __syncthreads();
        if (!more) break;
        d = dn; n0 = n1; it += F.G;
    }
}
constexpr int IT_S = (256 / 32) * (256 / 128);
constexpr int IT_LAYER = 2 * IT_S;
DI CvtDesc cvt_desc(const Args& a, int it) {
    const int l = it / IT_LAYER; int r = it % IT_LAYER;
    unsigned char* wl = a.ws + WS_W + (size_t)l * LW; const size_t oSS = (size_t)l * 65536;
    if (r < IT_S) return cvt_mk(a.in[I_WGLU] + oSS, 256, 256, nullptr, (bf16*)(wl + W_SMALL + S_WGLU), 0, 0, r, 0); r -= IT_S;
    return cvt_mk(a.in[I_CPW] + oSS, 256, 256, nullptr, (bf16*)(wl + W_SMALL + S_WPW), 0, 0, r, 0);
}
DI void prologue_weights(const Args& a, const Frame& F, int pmode = 0) {
    (void)pmode;
    prologue_weights_big(a, F);
    __syncthreads();
    LAS float* scr = (LAS float*)(F.lds + F.wave * 16768);
    const int gw = F.bid * NWAVES + F.wave, NGW = F.G * NWAVES, NIT = DEPTH * IT_LAYER;
    f32x2 wa[32];
    for (int it = gw; it < NIT; it += NGW) { const CvtDesc da = cvt_desc(a, it); cvt_load(da, F.lane, wa); cvt_store(da, F.lane, wa, scr); }
}

DI void prologue_tables(const Args& a, const Frame& F) {
    const int gt = F.bid * NTHR + F.tid, NGT = F.G * NTHR;
    unsigned char* ws = a.ws;
    for (int e = gt; e < DEPTH * 4 * 128 * 128; e += NGT) { const int l = e >> 16, r = e & 65535, i = (r >> 7) & 127, j = r & 127;
        const float v = (j <= i) ? a.in[I_GWS][e] : 0.f; ((bf16*)(ws + WS_W + (size_t)l * LW + W_SMALL + S_GMLPW))[r] = (bf16)f2bf(v); }
    for (int e16 = gt; e16 < DEPTH * 16 * 64 * 16; e16 += NGT) { const int e = e16 >> 4, c = e16 & 15, l = e >> 10, gp = e & 1023, g = gp >> 6, p = gp & 63;
        unsigned char* sm = ws + WS_W + (size_t)l * LW + W_SMALL;
        const float ar = a.in[I_AR][e], ai = a.in[I_AI][e], dt = expf(a.in[I_LDT][l * 16 + g]);
        const float br = a.in[I_BR][(size_t)e * 16 + c], bi = a.in[I_BI][(size_t)e * 16 + c];
        const size_t ce = ((size_t)(l * 16 + g) * 16 + c) * 64 + p;
        const float ccr = a.in[I_CR][ce], cci = a.in[I_CI][ce];
        float pw_re[3], pw_im[3];
#pragma unroll
        for (int q = 0; q < 3; ++q) { const float kk = (q == 0) ? 1.f : (q == 1 ? 64.f : 128.f);
            const double ang = (double)ai * (double)dt * (double)kk; const double nrot = rint(ang * 0.15915494309189535); const float rr = (float)(ang - nrot * 6.283185307179586);
            const float mag = expf(ar * dt * kk); pw_re[q] = mag * cosf(rr); pw_im[q] = mag * sinf(rr); }
        if (c == 0) {
            ((float*)(sm + S_AB))[gp * 2] = pw_re[0]; ((float*)(sm + S_AB))[gp * 2 + 1] = pw_im[0];
            ((float*)(sm + S_A64))[gp * 2] = pw_re[1]; ((float*)(sm + S_A64))[gp * 2 + 1] = pw_im[1];
            ((float*)(sm + S_A256))[gp * 2] = pw_re[2]; ((float*)(sm + S_A256))[gp * 2 + 1] = pw_im[2]; }
        const float nr = pw_re[0] - 1.f, ni = pw_im[0], den = ar * ar + ai * ai;
        const float cr = (nr * ar + ni * ai) / den, ci = (ni * ar - nr * ai) / den;
        bf16* bb = (bf16*)(sm + S_BBART); bf16* cm = (bf16*)(sm + S_CMT);
        bb[(g * 128 + p) * 16 + c] = (bf16)f2bf(cr * br - ci * bi); bb[(g * 128 + 64 + p) * 16 + c] = (bf16)f2bf(cr * bi + ci * br);
        cm[(g * 16 + c) * 128 + p] = (bf16)f2bf(ccr); cm[(g * 16 + c) * 128 + 64 + p] = (bf16)f2bf(-cci);
    }
    if (gt < DEPTH) { const int l = gt; float d1 = 0.f, d2 = 0.f;
        for (int i = 0; i < 32; ++i) { d1 += a.in[I_LQ1][l * 32 + i] * a.in[I_LK1][l * 32 + i]; d2 += a.in[I_LQ2][l * 32 + i] * a.in[I_LK2][l * 32 + i]; }
        const float lam_init = 0.8f - 0.6f * expf(-0.3f * (float)l);
        float* lp = (float*)(ws + WS_W + (size_t)l * LW + W_SMALL + S_LAM); lp[0] = expf(d1) - expf(d2) + lam_init; lp[1] = lam_init; }
}

template <int MODE>
DI void norm_phase(const Args& a, const Frame& F, int nslab, float sscale, float* RSTD, const float* SSP) {
    constexpr int RB = 3;
    const int gw = F.bid * NWAVES + F.wave, NGW = F.G * NWAVES;
    bf16* X = (bf16*)(a.ws + WS_X); const float* SL = (const float*)(a.ws + WS_SLAB);
    if (MODE == 0) {
        for (int row = F.bid * NTHR + F.tid; row < NP; row += F.G * NTHR) { const f32x4* q = (const f32x4*)(SSP + (size_t)row * 16); const f32x4 p = (q[0] + q[1]) + (q[2] + q[3]);
            RSTD[row] = 1.f / sqrtf(((p[0] + p[1]) + (p[2] + p[3])) * (1.f / DM) + EPS); }
    }
    const int r_lo = (MODE == 0) ? NP : 0;
    for (int rowb = r_lo + gw; rowb < MT; rowb += RB * NGW) {
        f32x4 v[RB][4]; int rows[RB]; bool ok[RB];
#pragma unroll
        for (int r = 0; r < RB; ++r) { const int row = rowb + r * NGW; ok[r] = row < MT; rows[r] = ok[r] ? row : rowb;
            if (MODE == 1) { const float* src = rows[r] < NP ? a.in[I_XP] + (size_t)rows[r] * DM : a.in[I_XS] + (size_t)(rows[r] - NP) * DM;
#pragma unroll
                for (int j = 0; j < 4; ++j) v[r][j] = ((const f32x4*)src)[F.lane + 64 * j]; }
            else { const u32x2* src = (const u32x2*)(X + (size_t)rows[r] * DM);
#pragma unroll
                for (int j = 0; j < 4; ++j) { const u32x2 w = src[F.lane + 64 * j]; v[r][j] = (f32x4){bflo(w.x), bfhi(w.x), bflo(w.y), bfhi(w.y)}; } } }
        if (MODE != 1 && nslab > 0) {
#pragma unroll
            for (int r = 0; r < RB; ++r) if (rows[r] >= NP) {
#pragma unroll
                for (int hb = 0; hb < 2; ++hb) {
                    u32x2 t[4][4];
#pragma unroll
                    for (int s4 = 0; s4 < 4; ++s4) { const int s = hb * 4 + s4; const u32x2* sp = (const u32x2*)((const bf16*)SL + ((size_t)(s < nslab ? s : 0) * NS + (rows[r] - NP)) * DM);
#pragma unroll
                        for (int j = 0; j < 4; ++j) t[s4][j] = sp[F.lane + 64 * j]; }
#pragma unroll
                    for (int s4 = 0; s4 < 4; ++s4) { const float wsc = (hb * 4 + s4 < nslab) ? sscale : 0.f;
#pragma unroll
                        for (int j = 0; j < 4; ++j) v[r][j] = v[r][j] + (f32x4){bflo(t[s4][j].x), bfhi(t[s4][j].x), bflo(t[s4][j].y), bfhi(t[s4][j].y)} * wsc; }
                }
            }
        }
        float ss[RB];
#pragma unroll
        for (int r = 0; r < RB; ++r) { ss[r] = 0.f;
#pragma unroll
            for (int j = 0; j < 4; ++j) ss[r] += (v[r][j][0] * v[r][j][0] + v[r][j][1] * v[r][j][1]) + (v[r][j][2] * v[r][j][2] + v[r][j][3] * v[r][j][3]); }
        wave_sum_n<RB>(ss);
#pragma unroll
        for (int r = 0; r < RB; ++r) if (ok[r]) { const int row = rows[r];
            const float rstd = 1.f / sqrtf(ss[r] * (1.f / DM) + EPS);
            if (MODE == 2) {
                float* o = (row < NP) ? a.out + O_YP + (size_t)row * DM : a.out + O_YS + (size_t)(row - NP) * DM;
#pragma unroll
                for (int j = 0; j < 4; ++j) { const f32x4 g = ((const f32x4*)a.in[I_FINAL])[F.lane + 64 * j]; ((f32x4*)o)[F.lane + 64 * j] = v[r][j] * rstd * g; }
            } else {
                if (F.lane == 0) RSTD[row] = rstd;
#pragma unroll
                for (int j = 0; j < 4; ++j) { u32x2 w; w.x = pk2(v[r][j][0], v[r][j][1]); w.y = pk2(v[r][j][2], v[r][j][3]); ((u32x2*)(X + (size_t)row * DM))[F.lane + 64 * j] = w; }
            }
        }
    }
}
DI void fill_rs_table(const Frame& F, const pg8::Sched& S, const float* RSTD) {
    LAS float* rs = (LAS float*)(F.lds + LDS_RS);
    for (int i = 0; i < 9; ++i) { pg8::Unit u; if (!S.next(i, u)) break;
        if (u.kind == 0 && F.tid < 256) rs[i * 256 + F.tid] = RSTD[u.pm * 256 + F.tid]; }
    __syncthreads();
}
DI void memnorm_phase(const Args& a, const Frame& F) {
    const int gw = F.bid * NWAVES + F.wave, NGW = F.G * NWAVES;
    bf16* MN = (bf16*)(a.ws + WS_MEMN);
    for (int row = gw; row < BP * NMEM; row += NGW) {
        const f32x4* src = (const f32x4*)(a.in[I_MEM] + (size_t)row * DM);
        f32x4 v[4]; float ss = 0.f;
#pragma unroll
        for (int j = 0; j < 4; ++j) { v[j] = src[F.lane + 64 * j]; ss += (v[j][0] * v[j][0] + v[j][1] * v[j][1]) + (v[j][2] * v[j][2] + v[j][3] * v[j][3]); }
        const float rstd = 1.f / sqrtf(wave_sum(ss) * (1.f / DM) + EPS);
        u32x2* o8 = (u32x2*)(MN + (size_t)row * DM);
#pragma unroll
        for (int j = 0; j < 4; ++j) { u32x2 w; w.x = pk2(v[j][0] * rstd, v[j][1] * rstd); w.y = pk2(v[j][2] * rstd, v[j][3] * rstd); o8[F.lane + 64 * j] = w; }
    }
}
#define MFMA16(a, b, c) __builtin_amdgcn_mfma_f32_16x16x32_bf16((a), (b), (c), 0, 0, 0)
constexpr int CNT_CONV = 0, CNT_GMLP = 1, CNT_ATTN = 2, CNT_SSM2 = 3, CNT_XATTN = 4, CNT_SSM1DONE = 10, CNT_CVT = 11;
DI gu32* cnt_word(const Frame& F, int l, int k) { return F.ctl + CW_CNT + 64 * (l * 16 + k); }
DI int next_unit(const Frame& F, gu32* ctr) {
    __syncthreads();
    if (F.tid == 0) F.MISC[4] = __hip_atomic_fetch_add(ctr, 1u, RLX_AGENT);
    __syncthreads();
    return __builtin_amdgcn_readfirstlane((int)F.MISC[4]);
}
DI unsigned deal_prefetch(const Frame& F, gu32* ctr) { unsigned t = 0u; if (F.tid == 0) t = __hip_atomic_fetch_add(ctr, 1u, RLX_AGENT); return t; }
DI int deal_publish(const Frame& F, unsigned t) {
    __syncthreads();
    if (F.tid == 0) F.MISC[4] = t;
    __syncthreads();
    return __builtin_amdgcn_readfirstlane((int)F.MISC[4]);
}
#define DEAL_LOOP(F, ctr, N, BODY) do { gu32* _c = (ctr); int u = F.bid; while (u < (N)) { const unsigned _t = deal_prefetch(F, _c); BODY; u = deal_publish(F, _t) + F.G; } __syncthreads(); } while (0)
#define DEAL_LOOP_DYN(F, ctr, N, BODY) do { gu32* _c = (ctr); int u = next_unit(F, _c); while (u < (N)) { const unsigned _t = deal_prefetch(F, _c); BODY; u = deal_publish(F, _t); } __syncthreads(); } while (0)
DI void signal_done(const Frame& F, gu32* ctr) { asm volatile("s_waitcnt vmcnt(0)" ::: "memory"); __syncthreads(); if (F.tid == 0) (void)__hip_atomic_fetch_add(ctr, 1u, RLX_AGENT); }
DI void signal_done_release(const Frame& F, gu32* ctr) {
    asm volatile("s_waitcnt vmcnt(0)" ::: "memory"); __syncthreads();
    if (F.tid == 0) { __builtin_amdgcn_fence(__ATOMIC_RELEASE, "agent"); asm volatile("s_waitcnt vmcnt(0)" ::: "memory"); (void)__hip_atomic_fetch_add(ctr, 1u, RLX_AGENT); }
}
DI void wait_done(const Frame& F, gu32* ctr, unsigned need) {
    if (F.tid == 0) { unsigned sp = 0; while (__hip_atomic_load(ctr, RLX_AGENT) < need) { __builtin_amdgcn_s_sleep(2); if (++sp > (1u << 22)) break; }
        __builtin_amdgcn_fence(__ATOMIC_ACQUIRE, "agent"); asm volatile("s_waitcnt vmcnt(0)" ::: "memory"); }
    __syncthreads();
}
DI bf16x8 zero8() { return (bf16x8){0, 0, 0, 0, 0, 0, 0, 0}; }
DI bf16x8 ld8g(const bf16* p) { return __builtin_bit_cast(bf16x8, *(const u32x4*)p); }
DI bf16x8 ld8l(const LAS unsigned char* p) { return *(const LAS bf16x8*)p; }
DI bf16x8 cat44(u32x2 lo, u32x2 hi) { u32x4 w; w.x = lo.x; w.y = lo.y; w.z = hi.x; w.w = hi.y; return __builtin_bit_cast(bf16x8, w); }
DI void lds_barrier() { asm volatile("s_waitcnt lgkmcnt(0)" ::: "memory"); __builtin_amdgcn_s_barrier(); asm volatile("" ::: "memory"); }
constexpr int CV_PER = 2;
static_assert(BT_LAYER % CV_PER == 0 && BT_EARLY % CV_PER == 0, "conversion units");
DI void cvt_unit(const Args& a, const Frame& F, int it0) {
    LAS float* T = (LAS float*)F.lds;
    int n0 = 0, n1 = 0; f32x4 w[16];
    BigDesc d = big_desc(a, it0, n0); big_load(d, F.tid, w);
#pragma unroll 1
    for (int i = 0; i < CV_PER; ++i) {
        big_to_lds(d, F.tid, w, T);
        lds_barrier();
        BigDesc dn = d;
        if (i + 1 < CV_PER) { dn = big_desc(a, it0 + i + 1, n1); big_load(dn, F.tid, w); }
        big_store(d, n0, F.tid, T);
        lds_barrier();
        d = dn; n0 = n1;
    }
}
typedef short v4i16_t __attribute__((ext_vector_type(4)));
DI u32x2 tr4(const LAS unsigned char* p) { return __builtin_bit_cast(u32x2, __builtin_amdgcn_ds_read_tr16_b64_v4i16((LAS v4i16_t*)p)); }
DI bf16x8 packp(f32x4 a, f32x4 b) { return __builtin_bit_cast(bf16x8, pack8(a, b)); }

DI void mm64_loadb(const bf16* WT, int wave, int lane, bf16x8 (&bfr)[2][8]) {
    const int fr = lane & 15, fq = lane >> 4;
#pragma unroll
    for (int ct = 0; ct < 2; ++ct)
#pragma unroll
        for (int ks = 0; ks < 8; ++ks) bfr[ct][ks] = ld8g(WT + (size_t)(32 * wave + 16 * ct + fr) * 256 + 32 * ks + 8 * fq);
}
DI void mm64_compute(const LAS unsigned char* A, int lda_b, const bf16x8 (&bfr)[2][8], int lane, f32x4 (&acc)[4][2]) {
    const int fr = lane & 15, fq = lane >> 4;
#pragma unroll
    for (int rt = 0; rt < 4; ++rt) { acc[rt][0] = (f32x4){0.f, 0.f, 0.f, 0.f}; acc[rt][1] = (f32x4){0.f, 0.f, 0.f, 0.f}; }
#pragma unroll
    for (int rt = 0; rt < 4; ++rt)
    {
        bf16x8 af[8];
#pragma unroll
        for (int ks = 0; ks < 8; ++ks) af[ks] = ld8l(A + (16 * rt + fr) * lda_b + (32 * ks + 8 * fq) * 2);
#pragma unroll
        for (int ks = 0; ks < 8; ++ks) { acc[rt][0] = MFMA16(af[ks], bfr[0][ks], acc[rt][0]); acc[rt][1] = MFMA16(af[ks], bfr[1][ks], acc[rt][1]); }
        __builtin_amdgcn_sched_barrier(0);
    }
}
DI void mm64(const LAS unsigned char* A, int lda_b, const bf16* WT, int wave, int lane, f32x4 (&acc)[4][2]) {
    bf16x8 bfr[2][8]; mm64_loadb(WT, wave, lane, bfr); mm64_compute(A, lda_b, bfr, lane, acc);
}

constexpr int SSM_WREG = 12800, SSM_BU = 0, SSM_S = 8448, SSM_G = 8 * SSM_WREG;
template <bool WRITE_S>
DI void ssm_block16(LAS unsigned char* wl, const bf16x8 uf, const bf16x8 (&bb)[8], float ar, float ai, float& sr, float& si, int lane) {
    const int fr = lane & 15, fq = lane >> 4;
    LAS float* BU = (LAS float*)(wl + SSM_BU);
#pragma unroll
    for (int nt = 0; nt < 8; ++nt) { const f32x4 c = MFMA16(uf, bb[nt], ((f32x4){0.f, 0.f, 0.f, 0.f}));
#pragma unroll
        for (int j = 0; j < 4; ++j) BU[(4 * fq + j) * 132 + 16 * nt + fr] = c[j]; }
    LDS_WAIT(); asm volatile("" ::: "memory");
    float bre[16], bim[16];
#pragma unroll
    for (int t = 0; t < 16; ++t) { bre[t] = BU[t * 132 + lane]; bim[t] = BU[t * 132 + 64 + lane]; }
    LAS bf16* S = (LAS bf16*)(wl + SSM_S);
#pragma unroll
    for (int t = 0; t < 16; ++t) { const float nr = ar * sr - ai * si + bre[t], ni = ar * si + ai * sr + bim[t]; sr = nr; si = ni;
        if (WRITE_S) { S[t * 136 + lane] = (bf16)f2bf(sr); S[t * 136 + 64 + lane] = (bf16)f2bf(si); } }
    LDS_WAIT(); asm volatile("" ::: "memory");
}
DI void ssm_load_bb(const bf16* BBT, int g, int lane, bf16x8 (&bb)[8]) {
    const int fr = lane & 15, fq = lane >> 4;
#pragma unroll
    for (int nt = 0; nt < 8; ++nt) bb[nt] = (fq < 2) ? ld8g(BBT + (size_t)(g * 128 + 16 * nt + fr) * 16 + 8 * fq) : zero8();
}
DI void ssm_pass1(const Args& a, const Frame& F, int l) {
    const unsigned char* sm = a.ws + WS_W + (size_t)l * LW + W_SMALL;
    const bf16* P = (const bf16*)(a.ws + WS_P); float* E = (float*)(a.ws + WS_SSME);
    LAS unsigned char* wl = F.lds + F.wave * SSM_WREG;
    const int lane = F.lane, fr = lane & 15, fq = lane >> 4;
    for (int task = F.bid + F.G * F.wave; task < BP * 16 * 32; task += F.G * NWAVES) {
        const int b = task >> 9, g = (task >> 5) & 15, sc = task & 31;
        const float ar = ((const float*)(sm + S_AB))[(g * 64 + lane) * 2], ai = ((const float*)(sm + S_AB))[(g * 64 + lane) * 2 + 1];
        bf16x8 bb[8]; ssm_load_bb((const bf16*)(sm + S_BBART), g, lane, bb);
        float sr = 0.f, si = 0.f;
        const bf16* up = P + (size_t)(b * TP + sc * 128 + fr) * INW + g * 16 + 8 * fq;
        bf16x8 un[4];
#pragma unroll
        for (int k = 0; k < 4; ++k) un[k] = (fq < 2) ? ld8g(up + (size_t)(16 * k) * INW) : zero8();
        for (int sub = 0; sub < 2; ++sub) {
            bf16x8 uc[4];
#pragma unroll
            for (int k = 0; k < 4; ++k) uc[k] = un[k];
            if (sub < 1) {
#pragma unroll
                for (int k = 0; k < 4; ++k) un[k] = (fq < 2) ? ld8g(up + (size_t)(64 * (sub + 1) + 16 * k) * INW) : zero8(); }
#pragma unroll
            for (int k = 0; k < 4; ++k) ssm_block16<false>(wl, uc[k], bb, ar, ai, sr, si, lane);
            { const unsigned long long ev = (unsigned long long)__builtin_bit_cast(unsigned, sr) | ((unsigned long long)__builtin_bit_cast(unsigned, si) << 32);
              __hip_atomic_store((GAS unsigned long long*)(E + ((((size_t)(b * 32 + sc) * 2 + sub) * 16 + g) * 64 + lane) * 2), ev, RLX_AGENT); }
        }
    }
}
DI void ssm_pass2_unit(const Args& a, const Frame& F, int l, int unit) {
    const unsigned char* sm = a.ws + WS_W + (size_t)l * LW + W_SMALL;
    const bf16* P = (const bf16*)(a.ws + WS_P); const float* E = (const float*)(a.ws + WS_SSME); bf16* MIX = (bf16*)(a.ws + WS_MIX);
    int lane = F.lane; asm volatile("" : "+v"(lane));
    const int fr = lane & 15, fq = lane >> 4;
    const bool prompt = unit < 256; const int b = prompt ? (unit >> 6) : (unit - 256), ck = prompt ? (unit & 63) : 0;
    const int row0 = prompt ? b * TP + ck * 64 : NP + b * 64;
    LAS unsigned char* wl = F.lds + F.wave * SSM_WREG; LAS bf16* G = (LAS bf16*)(F.lds + SSM_G);
    for (int gi = 0; gi < 2; ++gi) {
        const int g = 2 * F.wave + gi;
        const float ar = ((const float*)(sm + S_AB))[(g * 64 + lane) * 2], ai = ((const float*)(sm + S_AB))[(g * 64 + lane) * 2 + 1];
        float sr, si;
        if (prompt) {
            const int sc = ck >> 1, sub = ck & 1;
            const float a128r = ((const float*)(sm + S_A256))[(g * 64 + lane) * 2], a128i = ((const float*)(sm + S_A256))[(g * 64 + lane) * 2 + 1];
            sr = 0.f; si = 0.f;
#pragma unroll
            for (int hb = 0; hb < 2; ++hb) {
                float er[16], ei[16];
#pragma unroll
                for (int j = 0; j < 16; ++j) { const int jj = hb * 16 + j; const float* e = E + ((((size_t)(b * 32 + (jj < 31 ? jj : 30)) * 2 + 1) * 16 + g) * 64 + lane) * 2; er[j] = e[0]; ei[j] = e[1]; }
#pragma unroll
                for (int j = 0; j < 16; ++j) { const float nr = a128r * sr - a128i * si + er[j], ni = a128r * si + a128i * sr + ei[j]; if (hb * 16 + j < sc) { sr = nr; si = ni; } }
            }
            if (sub > 0) {
                const float a64r = ((const float*)(sm + S_A64))[(g * 64 + lane) * 2], a64i = ((const float*)(sm + S_A64))[(g * 64 + lane) * 2 + 1];
                const float* e = E + ((((size_t)(b * 32 + sc) * 2 + 0) * 16 + g) * 64 + lane) * 2;
                const float nr = a64r * sr - a64i * si + e[0], ni = a64r * si + a64i * sr + e[1]; sr = nr; si = ni; }
        } else {
            sr = a.in[I_SRE][((size_t)(l * BS + b) * 16 + g) * 64 + lane]; si = a.in[I_SIM][((size_t)(l * BS + b) * 16 + g) * 64 + lane];
        }
        bf16x8 bb[8]; ssm_load_bb((const bf16*)(sm + S_BBART), g, lane, bb);
        bf16x8 cm[4];
#pragma unroll
        for (int ks = 0; ks < 4; ++ks) cm[ks] = ld8g((const bf16*)(sm + S_CMT) + (size_t)(g * 16 + fr) * 128 + 32 * ks + 8 * fq);
        bf16x8 df; { const unsigned short dv = (unsigned short)f2bf(a.in[I_SD][l * 256 + g * 16 + fr]);
#pragma unroll
            for (int j = 0; j < 8; ++j) df[j] = (fq < 2 && 8 * fq + j == fr) ? (short)dv : (short)0; }
        const bf16* up = P + (size_t)(row0 + fr) * INW + g * 16 + 8 * fq;
        bf16x8 uc[4];
#pragma unroll
        for (int k = 0; k < 4; ++k) uc[k] = (fq < 2) ? ld8g(up + (size_t)(16 * k) * INW) : zero8();
#pragma unroll
        for (int k = 0; k < 4; ++k) {
            ssm_block16<true>(wl, uc[k], bb, ar, ai, sr, si, lane);
            f32x4 y = (f32x4){0.f, 0.f, 0.f, 0.f};
#pragma unroll
            for (int ks = 0; ks < 4; ++ks) y = MFMA16(ld8l(wl + SSM_S + (fr * 136 + 32 * ks + 8 * fq) * 2), cm[ks], y);
            y = MFMA16(uc[k], df, y);
#pragma unroll
            for (int j = 0; j < 4; ++j) G[(16 * k + 4 * fq + j) * 264 + g * 16 + fr] = (bf16)f2bf(gelu_tanh(y[j]));
        }
        if (!prompt || ck == 63) {
            float* orp = prompt ? a.out + O_PSR + ((size_t)(l * BP + b) * 16 + g) * 64 : a.out + O_SSR + ((size_t)(l * BS + b) * 16 + g) * 64;
            float* oip = prompt ? a.out + O_PSI + ((size_t)(l * BP + b) * 16 + g) * 64 : a.out + O_SSI + ((size_t)(l * BS + b) * 16 + g) * 64;
            orp[lane] = sr; oip[lane] = si; }
    }
    __syncthreads();
    f32x4 acc[4][2];
    mm64((const LAS unsigned char*)G, 528, (const bf16*)(sm + S_WGLU), F.wave, lane, acc);
#pragma unroll
    for (int ct = 0; ct < 2; ++ct) { const int n = 32 * F.wave + 16 * ct + fr; const float bg = a.in[I_BGLU][l * 256 + n];
#pragma unroll
        for (int rt = 0; rt < 4; ++rt)
#pragma unroll
            for (int j = 0; j < 4; ++j) { const int t = 16 * rt + 4 * fq + j; const float gv = bf2f(G[t * 264 + n]);
                ((LAS bf16*)F.lds)[t * 264 + n] = (bf16)f2bf(gv * sigmoidf_(acc[rt][ct][j] + bg)); } }
    __syncthreads();
#pragma unroll
    for (int k = 0; k < 4; ++k) { const int e = F.tid + k * NTHR, t = e >> 5, c8 = (e & 31) * 8;
        *(u32x4*)(MIX + (size_t)(row0 + t) * DM + c8) = *(const LAS u32x4*)((LAS bf16*)F.lds + t * 264 + c8); }
}

constexpr int CV_Z = 0, CV_Y = 49152, CV_A = 0;
DI void conv_unit(const Args& a, const Frame& F, int l, int unit) {
    const unsigned char* sm = a.ws + WS_W + (size_t)l * LW + W_SMALL;
    const bf16* P = (const bf16*)(a.ws + WS_P); bf16* MIX = (bf16*)(a.ws + WS_MIX);
    int lane = F.lane, tid = F.tid;
    asm volatile("" : "+v"(lane), "+v"(tid));
    const bool prompt = unit < 256; const int b = prompt ? (unit >> 6) : (unit - 256), tt = prompt ? (unit & 63) : 0;
    const int row0 = prompt ? b * TP + tt * 64 : NP + b * 64;
    LAS bf16* Z = (LAS bf16*)(F.lds + CV_Z); LAS float* Y = (LAS float*)(F.lds + CV_Y);
    const bool wbuf = !prompt || tt == 63;
    float* obuf = prompt ? a.out + O_PCV + (size_t)(l * BP + b) * 30 * 256 : a.out + O_SCV + (size_t)(l * BS + b) * 30 * 256;
    float w[31];
#pragma unroll
    for (int k = 0; k < 31; ++k) w[k] = a.in[I_CW][((size_t)l * 31 + k) * 256 + (tid & 255)];
    const float cb = a.in[I_CB][l * 256 + (tid & 255)];
    bf16x8 bfr[2][8]; mm64_loadb((const bf16*)(sm + S_WPW), F.wave, lane, bfr);
    const bool first = !prompt || tt == 0;
    if (first) {
        for (int e = tid; e < 30 * 32; e += NTHR) { const int i = e >> 5, c8 = (e & 31) * 8;
            u32x4 w = (u32x4){0u, 0u, 0u, 0u};
            if (!prompt) { const f32x4* sp = (const f32x4*)(a.in[I_SCONV] + ((size_t)(l * BS + b) * 30 + i) * 256 + c8); w = pack8(sp[0], sp[1]); }
            *(LAS u32x4*)(Z + i * 256 + c8) = w; }
    }
    {
        const int i0 = first ? 30 : 0, nch = (94 - i0) * 32;
        for (int eb = 0; eb < nch; eb += 3 * NTHR) {
            u32x4 av[3], gv[3];
#pragma unroll
            for (int r = 0; r < 3; ++r) { int e = eb + r * NTHR + tid; e = e < nch ? e : nch - 1; const int i = i0 + (e >> 5), c8 = (e & 31) * 8;
                const bf16* pr = P + (size_t)(row0 - 30 + i) * INW + 1024 + c8; av[r] = *(const u32x4*)pr; gv[r] = *(const u32x4*)(pr + 256); }
#pragma unroll
            for (int r = 0; r < 3; ++r) { const int e = eb + r * NTHR + tid; if (e < nch) { const int i = i0 + (e >> 5), c8 = (e & 31) * 8;
                float z[8];
#pragma unroll
                for (int q = 0; q < 4; ++q) { z[2 * q] = bflo(av[r][q]) * sigmoidf_(bflo(gv[r][q])); z[2 * q + 1] = bfhi(av[r][q]) * sigmoidf_(bfhi(gv[r][q])); }
                u32x4 w; w.x = pk2(z[0], z[1]); w.y = pk2(z[2], z[3]); w.z = pk2(z[4], z[5]); w.w = pk2(z[6], z[7]);
                *(LAS u32x4*)(Z + i * 256 + c8) = w;
                if (wbuf && i >= 64) { f32x4* o = (f32x4*)(obuf + (size_t)(i - 64) * 256 + c8); o[0] = (f32x4){z[0], z[1], z[2], z[3]}; o[1] = (f32x4){z[4], z[5], z[6], z[7]}; } } }
        }
    }
    __syncthreads();
    {
        const int c = tid & 255, th = tid >> 8;
#pragma unroll 1
        for (int tg = 0; tg < 8; ++tg) { const int t = th * 32 + tg * 4;
            float zz[34];
#pragma unroll
            for (int k = 0; k < 34; ++k) zz[k] = bf2f(Z[(t + k) * 256 + c]);
#pragma unroll
            for (int q = 0; q < 4; ++q) { float s = cb;
#pragma unroll
                for (int k = 0; k < 31; ++k) s += w[k] * zz[k + q];
                Y[(t + q) * 260 + c] = s; } }
    }
    __syncthreads();
    {
        const f32x4 lg = ((const f32x4*)(a.in[I_CLG] + l * 256))[lane], lb = ((const f32x4*)(a.in[I_CLB] + l * 256))[lane];
        LAS unsigned char* A = F.lds + CV_A;
        f32x4 v[8]; float st[16];
#pragma unroll
        for (int r = 0; r < 8; ++r) { v[r] = *(const LAS f32x4*)(Y + (8 * F.wave + r) * 260 + 4 * lane);
            st[r] = (v[r][0] + v[r][1]) + (v[r][2] + v[r][3]); st[8 + r] = (v[r][0] * v[r][0] + v[r][1] * v[r][1]) + (v[r][2] * v[r][2] + v[r][3] * v[r][3]); }
        wave_sum_n<16>(st);
#pragma unroll
        for (int r = 0; r < 8; ++r) { const int t = 8 * F.wave + r; const float mu = st[r] * (1.f / 256.f); const float var = fmaxf(st[8 + r] * (1.f / 256.f) - mu * mu, 0.f); const float rstd = 1.f / sqrtf(var + EPS);
            f32x4 o;
#pragma unroll
            for (int q = 0; q < 4; ++q) o[q] = siluf_((v[r][q] - mu) * rstd * lg[q] + lb[q]);
            u32x2 wv; wv.x = pk2(o[0], o[1]); wv.y = pk2(o[2], o[3]); *(LAS u32x2*)(A + t * 528 + lane * 8) = wv; }
    }
    __syncthreads();
    f32x4 acc[4][2];
    mm64_compute(F.lds + CV_A, 528, bfr, lane, acc);
    const int fr = lane & 15, fq = lane >> 4;
#pragma unroll
    for (int ct = 0; ct < 2; ++ct) { const int n = 32 * F.wave + 16 * ct + fr;
#pragma unroll
        for (int rt = 0; rt < 4; ++rt)
#pragma unroll
            for (int j = 0; j < 4; ++j) ((LAS bf16*)(F.lds + CV_Y))[(16 * rt + 4 * fq + j) * 264 + n] = (bf16)f2bf(acc[rt][ct][j]); }
    __syncthreads();
#pragma unroll
    for (int k = 0; k < 4; ++k) { const int e = tid + k * NTHR, t = e >> 5, c8 = (e & 31) * 8;
        *(u32x4*)(MIX + (size_t)(row0 + t) * DM + 512 + c8) = *(const LAS u32x4*)((LAS bf16*)(F.lds + CV_Y) + t * 264 + c8); }
}

template <int L>
DI void gmlp_unit_t(const Args& a, const Frame& F, int l, int row0, float* gv_out) {
    const unsigned char* sm = a.ws + WS_W + (size_t)l * LW + W_SMALL;
    const bf16* P = (const bf16*)(a.ws + WS_P); bf16* MIX = (bf16*)(a.ws + WS_MIX);
    const int lane = F.lane, fr = lane & 15, fq = lane >> 4;
    LAS unsigned char* VL = F.lds;
    const int h = F.wave >> 1; const bf16* Wm = (const bf16*)(sm + S_GMLPW) + (size_t)h * 128 * 128;
    bf16x8 af[L / 32][L / 32]; float bsv[L / 32][4];
#pragma unroll
    for (int r = 0; r < L / 32; ++r) { const int it = (F.wave & 1) * (L / 32) + r;
#pragma unroll
        for (int ks = 0; ks < L / 32; ++ks) { const bf16* wr_ = Wm + (size_t)(16 * it + fr) * 128 + 32 * ks + 4 * fq; af[r][ks] = cat44(*(const u32x2*)wr_, *(const u32x2*)(wr_ + 16)); }
#pragma unroll
        for (int j = 0; j < 4; ++j) bsv[r][j] = a.in[I_GBS][(l * 4 + h) * 128 + 16 * it + 4 * fq + j]; }
    {
        const f32x4 lg = ((const f32x4*)(a.in[I_GLG] + l * 256))[lane], lb = ((const f32x4*)(a.in[I_GLB] + l * 256))[lane];
        for (int t0 = F.wave; t0 < L; t0 += 4 * NWAVES) {
            u32x2 raw[4];
#pragma unroll
            for (int r = 0; r < 4; ++r) raw[r] = *(const u32x2*)(P + (size_t)(row0 + t0 + r * NWAVES) * INW + 1792 + 4 * lane);
            f32x4 v[4]; float st[8];
#pragma unroll
            for (int r = 0; r < 4; ++r) { v[r] = (f32x4){bflo(raw[r].x), bfhi(raw[r].x), bflo(raw[r].y), bfhi(raw[r].y)};
                st[r] = (v[r][0] + v[r][1]) + (v[r][2] + v[r][3]); st[4 + r] = (v[r][0] * v[r][0] + v[r][1] * v[r][1]) + (v[r][2] * v[r][2] + v[r][3] * v[r][3]); }
            wave_sum_n<8>(st);
#pragma unroll
            for (int r = 0; r < 4; ++r) { const int t = t0 + r * NWAVES;
                const float mu = st[r] * (1.f / 256.f); const float var = fmaxf(st[4 + r] * (1.f / 256.f) - mu * mu, 0.f); const float rstd = 1.f / sqrtf(var + EPS);
                const f32x4 o = (v[r] - mu) * rstd * lg + lb;
                if (gv_out) *(f32x4*)(gv_out + (size_t)t * 256 + 4 * lane) = o;
                u32x2 wv; wv.x = pk2(o[0], o[1]); wv.y = pk2(o[2], o[3]); *(LAS u32x2*)(VL + t * 544 + lane * 8) = wv; }
        }
    }
    __syncthreads();
    constexpr int NRT = L / 32;
    LAS bf16* MX = (LAS bf16*)(F.lds + 69632);
#pragma unroll
    for (int r = 0; r < NRT; ++r) {
        const int it = (F.wave & 1) * NRT + r, ksn = it / 2 + 1;
        f32x4 acc[4];
#pragma unroll
        for (int dt = 0; dt < 4; ++dt) acc[dt] = (f32x4){0.f, 0.f, 0.f, 0.f};
#pragma unroll
        for (int ks = 0; ks < L / 32; ++ks) if (ks < ksn) {
#pragma unroll
            for (int dt = 0; dt < 4; ++dt) { const LAS unsigned char* vr = VL + (32 * ks + 4 * fq + (fr >> 2)) * 544 + (h * 64 + 16 * dt + 4 * (fr & 3)) * 2;
                acc[dt] = MFMA16(af[r][ks], cat44(tr4(vr), tr4(vr + 16 * 544)), acc[dt]); } }
#pragma unroll
        for (int j = 0; j < 4; ++j) { const int i = 16 * it + 4 * fq + j;
#pragma unroll
            for (int dt = 0; dt < 4; ++dt) MX[i * 264 + h * 64 + 16 * dt + fr] = (bf16)f2bf(acc[dt][j] + bsv[r][j]); }
    }
    __syncthreads();
    {
        constexpr int NCH = L * 32 / NTHR;
        u32x4 uv[NCH];
#pragma unroll
        for (int k = 0; k < NCH; ++k) { const int e = F.tid + k * NTHR, i = e >> 5, c8 = (e & 31) * 8; uv[k] = *(const u32x4*)(P + (size_t)(row0 + i) * INW + 1536 + c8); }
#pragma unroll
        for (int k = 0; k < NCH; ++k) { const int e = F.tid + k * NTHR, i = e >> 5, c8 = (e & 31) * 8; const u32x4 mv = *(const LAS u32x4*)(MX + i * 264 + c8);
            u32x4 o;
#pragma unroll
            for (int q = 0; q < 4; ++q) o[q] = pk2(bflo(uv[k][q]) * bflo(mv[q]), bfhi(uv[k][q]) * bfhi(mv[q]));
            *(u32x4*)(MIX + (size_t)(row0 + i) * DM + 768 + c8) = o; }
    }
}
DI void gmlp_unit(const Args& a, const Frame& F, int l, int unit) {
    if (unit < 128) gmlp_unit_t<128>(a, F, l, (unit >> 5) * TP + (unit & 31) * 128, nullptr);
    else { const int b = unit - 128; gmlp_unit_t<64>(a, F, l, NP + b * 64, a.out + O_SGV + (size_t)(l * BS + b) * 64 * 256); }
}

constexpr int AT_K = 0, AT_V = 17408, AT_BUF = 35840;
struct AtRaw { f32x4 k[2][2], v[2][2]; };
DI void at_issue(AtRaw& r, const void* kp, const void* vp, size_t rowstride_b, bool f32src, int tid) {
#pragma unroll
    for (int c = 0; c < 2; ++c) { const int e = tid + c * NTHR, key = e >> 4, c8 = (e & 15) * 8;
        const char* k0 = (const char*)kp + key * rowstride_b + (f32src ? c8 * 4 : c8 * 2); const char* v0 = (const char*)vp + key * rowstride_b + (f32src ? c8 * 4 : c8 * 2);
        const int o2 = f32src ? 16 : 0;
        r.k[c][0] = *(const f32x4*)k0; r.k[c][1] = *(const f32x4*)(k0 + o2); r.v[c][0] = *(const f32x4*)v0; r.v[c][1] = *(const f32x4*)(v0 + o2); }
}
DI void at_commit(const AtRaw& r, LAS unsigned char* buf, bool f32src, int tid) {
#pragma unroll
    for (int c = 0; c < 2; ++c) { const int e = tid + c * NTHR, key = e >> 4, c8 = (e & 15) * 8;
        const u32x4 kc = pack8(r.k[c][0], r.k[c][1]), vc = pack8(r.v[c][0], r.v[c][1]);
        const u32x4 kb = __builtin_bit_cast(u32x4, r.k[c][0]), vb = __builtin_bit_cast(u32x4, r.v[c][0]);
        u32x4 kw, vw;
#pragma unroll
        for (int q = 0; q < 4; ++q) { kw[q] = f32src ? kc[q] : kb[q]; vw[q] = f32src ? vc[q] : vb[q]; }
        *(LAS u32x4*)(buf + AT_K + key * 272 + c8 * 2) = kw;
        *(LAS u32x4*)(buf + AT_V + key * 288 + c8 * 2) = vw; }
}
DI void at_src(int kt, int nf32, const float* ck, const float* cv, const bf16* P, int prow0, int hp, const void*& kp, const void*& vp, size_t& rs, bool& f32s) {
    if (kt < nf32) { kp = ck + (size_t)(kt * 64) * 256 + hp * 128; vp = cv + (size_t)(kt * 64) * 256 + hp * 128; rs = 1024; f32s = true; }
    else { const bf16* pb = P + (size_t)(prow0 + (kt - nf32) * 64) * INW + hp * 128; kp = pb + 512; vp = pb + 768; rs = INW * 2; f32s = false; }
}
struct AtRawB { u32x4 k[2], v[2]; };
DI void atb_issue(AtRawB& r, const char* tb, unsigned voff) {
#pragma unroll
    for (int c = 0; c < 2; ++c) { const char* p = tb + (voff + (unsigned)c * (32u * INW * 2u));
        r.k[c] = *(const u32x4*)p; r.v[c] = *(const u32x4*)(p + 512); }
}
DI void atb_commit(const AtRawB& r, LAS unsigned char* buf, int tid) {
#pragma unroll
    for (int c = 0; c < 2; ++c) { const int e = tid + c * NTHR, key = e >> 4, c8 = (e & 15) * 8;
        *(LAS u32x4*)(buf + AT_K + key * 272 + c8 * 2) = r.k[c]; *(LAS u32x4*)(buf + AT_V + key * 288 + c8 * 2) = r.v[c]; }
}
struct AtState { float ref, l1, l2; f32x4 O1[4], O2[4], cinit[4]; };
DI void at_qk(f32x4 (&s1)[4], f32x4 (&s2)[4], const LAS unsigned char* buf, const bf16x8 q1, const bf16x8 q2, const f32x4 (&ci)[4], int hh, int fr, int fq) {
#pragma unroll
    for (int k4 = 0; k4 < 4; ++k4) { const LAS unsigned char* kr = buf + AT_K + (16 * k4 + fr) * 272 + hh * 128 + fq * 16;
        s1[k4] = MFMA16(ld8l(kr), q1, ci[k4]); s2[k4] = MFMA16(ld8l(kr + 64), q2, ci[k4]); }
}
DI void at_exp(f32x4 (&s1)[4], f32x4 (&s2)[4], float& ps1, float& ps2) {
    f32x4 a1 = (f32x4){0.f, 0.f, 0.f, 0.f}, a2 = a1;
#pragma unroll
    for (int k4 = 0; k4 < 4; ++k4) {
#pragma unroll
        for (int j = 0; j < 4; ++j) { s1[k4][j] = fast_exp2(s1[k4][j]); s2[k4][j] = fast_exp2(s2[k4][j]); }
        a1 = a1 + s1[k4]; a2 = a2 + s2[k4]; }
    ps1 = (a1[0] + a1[1]) + (a1[2] + a1[3]); ps2 = (a2[0] + a2[1]) + (a2[2] + a2[3]);
}
DI void at_pv(AtState& S, const f32x4 (&s1)[4], const f32x4 (&s2)[4], float alpha, float ps1, float ps2, const LAS unsigned char* buf, int hh, int fq, int tq, int tp) {
    S.l1 = S.l1 * alpha + ps1; S.l2 = S.l2 * alpha + ps2;
#pragma unroll
    for (int dt = 0; dt < 4; ++dt) { S.O1[dt] = S.O1[dt] * alpha; S.O2[dt] = S.O2[dt] * alpha; }
    bf16x8 p1[2], p2[2];
#pragma unroll
    for (int s = 0; s < 2; ++s) { p1[s] = packp(s1[2 * s], s1[2 * s + 1]); p2[s] = packp(s2[2 * s], s2[2 * s + 1]); }
#pragma unroll
    for (int dh = 0; dh < 2; ++dh) {
        bf16x8 vt[2][2];
#pragma unroll
        for (int d2 = 0; d2 < 2; ++d2)
#pragma unroll
            for (int s = 0; s < 2; ++s) { const int dt = 2 * dh + d2; const LAS unsigned char* vr = buf + AT_V + (32 * s + 4 * fq + tq) * 288 + (hh * 64 + 16 * dt + 4 * tp) * 2; vt[d2][s] = cat44(tr4(vr), tr4(vr + 16 * 288)); }
        __builtin_amdgcn_s_setprio(1);
#pragma unroll
        for (int s = 0; s < 2; ++s)
#pragma unroll
            for (int d2 = 0; d2 < 2; ++d2) { const int dt = 2 * dh + d2; S.O1[dt] = MFMA16(vt[d2][s], p1[s], S.O1[dt]); S.O2[dt] = MFMA16(vt[d2][s], p2[s], S.O2[dt]); }
        __builtin_amdgcn_s_setprio(0);
        __builtin_amdgcn_sched_barrier(0);
    }
}
template <int VAR>
DI void attn_tile(AtState& S, const LAS unsigned char* buf, const bf16x8 q1, const bf16x8 q2, int kt, bool diag, int qpos0, int qpos_l, float slope2, float adv, float decay, int hh, int fr, int fq) {
    const int tq = fr >> 2, tp = fr & 3;
    const bool exact = diag || kt == 0;
    f32x4 s1[4], s2[4]; float ps1, ps2;
    if (exact) {
        asm volatile("; attention: exact tile" ::: "memory");
        { f32x4 z[4];
#pragma unroll
          for (int k4 = 0; k4 < 4; ++k4) z[k4] = (f32x4){0.f, 0.f, 0.f, 0.f};
          at_qk(s1, s2, buf, q1, q2, z, hh, fr, fq); }
        int ql = qpos_l - 4 * fq; asm volatile("" : "+v"(ql));
        const float dk = slope2 * (float)(qpos0 - kt * 64);
        float mx = -1e30f;
#pragma unroll
        for (int k4 = 0; k4 < 4; ++k4)
#pragma unroll
            for (int j = 0; j < 4; ++j) { const float g = slope2 * (float)(16 * k4 + j - ql); const float bias = diag ? -fabsf(g) : g - dk;
                s1[k4][j] += bias; s2[k4][j] += bias; mx = fmaxf(mx, fmaxf(s1[k4][j], s2[k4][j])); }
        mx = fmaxf(mx, __shfl_xor(mx, 16)); mx = fmaxf(mx, __shfl_xor(mx, 32));
        const float nref = fmaxf(S.ref, mx);
        const float alpha = fast_exp2(S.ref - nref); S.ref = nref;
#pragma unroll
        for (int k4 = 0; k4 < 4; ++k4) { s1[k4] = s1[k4] - nref; s2[k4] = s2[k4] - nref; }
        if (kt == 0) { const float c0 = -slope2 * (float)qpos0 - S.ref;
#pragma unroll
            for (int k4 = 0; k4 < 4; ++k4)
#pragma unroll
                for (int j = 0; j < 4; ++j) S.cinit[k4][j] = slope2 * (float)(16 * k4 + j - ql) + c0; }
        at_exp(s1, s2, ps1, ps2);
        at_pv(S, s1, s2, alpha, ps1, ps2, buf, hh, fq, tq, tp);
    } else {
        asm volatile("; attention: fast tile" ::: "memory");
        at_qk(s1, s2, buf, q1, q2, S.cinit, hh, fr, fq);
        S.ref += adv;
        at_exp(s1, s2, ps1, ps2);
        if (__any(!(ps1 + ps2 < 0x1p60f))) {
            asm volatile("; attention: bump" ::: "memory");
            at_qk(s1, s2, buf, q1, q2, S.cinit, hh, fr, fq);
            float lm = -1e30f;
#pragma unroll
            for (int k4 = 0; k4 < 4; ++k4)
#pragma unroll
                for (int j = 0; j < 4; ++j) lm = fmaxf(lm, fmaxf(s1[k4][j], s2[k4][j]));
            lm = fmaxf(lm, __shfl_xor(lm, 16)); lm = fmaxf(lm, __shfl_xor(lm, 32));
            const float bump = fmaxf(lm, 0.f);
            const float alpha = decay * fast_exp2(-bump); S.ref += bump;
#pragma unroll
            for (int k4 = 0; k4 < 4; ++k4) { s1[k4] = s1[k4] - bump; s2[k4] = s2[k4] - bump; S.cinit[k4] = S.cinit[k4] - bump; }
            at_exp(s1, s2, ps1, ps2);
            at_pv(S, s1, s2, alpha, ps1, ps2, buf, hh, fq, tq, tp);
        } else {
            asm volatile("; attention: fast tail" ::: "memory");
            at_pv(S, s1, s2, decay, ps1, ps2, buf, hh, fq, tq, tp);
        }
    }
}
template <int VAR>
DI void attn_segment(const Args& a, const Frame& F, int l, int qrow0, int qpos0, int hp, int ntile, int nf32, const float* ck, const float* cv, int prow0) {
    const unsigned char* sm = a.ws + WS_W + (size_t)l * LW + W_SMALL;
    const bf16* P = (const bf16*)(a.ws + WS_P); bf16* MIX = (bf16*)(a.ws + WS_MIX);
    int lane = F.lane, tid = F.tid, wave = F.wave;
    asm volatile("" : "+v"(lane), "+v"(tid)); asm volatile("" : "+s"(wave));
    const int fr = lane & 15, fq = lane >> 4;
    const int hh = wave >> 2, h = 2 * hp + hh, qr = (wave & 3) * 16;
    const float slope2 = exp2f(-2.f * (float)(h + 1)) * LOG2E;
    const bf16* qp = P + (size_t)(qrow0 + qr + fr) * INW + 256 + h * 64 + 8 * fq;
    const bf16x8 q1 = ld8g(qp), q2 = ld8g(qp + 32);
    const int qpos_l = qr + fr;
    const float adv = 64.f * slope2, decay = fast_exp2(-adv);
    AtState S; S.ref = -1e30f; S.l1 = 0.f; S.l2 = 0.f;
#pragma unroll
    for (int dt = 0; dt < 4; ++dt) { S.O1[dt] = (f32x4){0.f, 0.f, 0.f, 0.f}; S.O2[dt] = (f32x4){0.f, 0.f, 0.f, 0.f};
#pragma unroll
        for (int j = 0; j < 4; ++j) S.cinit[dt][j] = 0.f; }
    if (nf32 == 0) {
        const char* pb = (const char*)(P + (size_t)prow0 * INW + 512 + hp * 128);
        const unsigned voff = (unsigned)((tid >> 4) * INW + (tid & 15) * 8) * 2u; constexpr size_t TSTR = (size_t)64 * INW * 2;
        AtRawB ra, rb;
        atb_issue(ra, pb, voff); atb_commit(ra, F.lds, tid);
        const int nl = ntile - 1;
        atb_issue(ra, pb + (size_t)(nl < 1 ? nl : 1) * TSTR, voff);
        lds_barrier();
        for (int kt = 0; kt < ntile; kt += 2) {
            atb_issue(rb, pb + (size_t)(kt + 2 < nl ? kt + 2 : nl) * TSTR, voff);
            attn_tile<VAR>(S, F.lds + (kt & 1) * AT_BUF, q1, q2, kt, kt + 1 == ntile, qpos0, qpos_l, slope2, adv, decay, hh, fr, fq);
            atb_commit(ra, F.lds + ((kt + 1) & 1) * AT_BUF, tid);
            lds_barrier();
            if (kt + 1 >= ntile) break;
            atb_issue(ra, pb + (size_t)(kt + 3 < nl ? kt + 3 : nl) * TSTR, voff);
            attn_tile<VAR>(S, F.lds + ((kt + 1) & 1) * AT_BUF, q1, q2, kt + 1, kt + 2 == ntile, qpos0, qpos_l, slope2, adv, decay, hh, fr, fq);
            atb_commit(rb, F.lds + (kt & 1) * AT_BUF, tid);
            lds_barrier();
        }
    } else {
        AtRaw raw;
        { const void *kp, *vp; size_t rs; bool f32s; at_src(0, nf32, ck, cv, P, prow0, hp, kp, vp, rs, f32s); at_issue(raw, kp, vp, rs, f32s, tid); at_commit(raw, F.lds, f32s, tid); }
        lds_barrier();
        for (int kt = 0; kt < ntile; ++kt) {
            const bool more = kt + 1 < ntile; bool nf32s = false;
            if (more) { const void *kp, *vp; size_t rs; at_src(kt + 1, nf32, ck, cv, P, prow0, hp, kp, vp, rs, nf32s); at_issue(raw, kp, vp, rs, nf32s, tid); }
            attn_tile<VAR>(S, F.lds + (kt & 1) * AT_BUF, q1, q2, kt, !more, qpos0, qpos_l, slope2, adv, decay, hh, fr, fq);
            if (more) at_commit(raw, F.lds + ((kt + 1) & 1) * AT_BUF, nf32s, tid);
            lds_barrier();
        }
    }
    float l1 = S.l1, l2 = S.l2;
    l1 += __shfl_xor(l1, 16); l1 += __shfl_xor(l1, 32); l2 += __shfl_xor(l2, 16); l2 += __shfl_xor(l2, 32);
    const float lam = ((const float*)(sm + S_LAM))[0], lam_init = ((const float*)(sm + S_LAM))[1];
    const float i1 = 1.f / l1, i2 = lam / l2;
    float ss = 0.f;
#pragma unroll
    for (int dt = 0; dt < 4; ++dt)
#pragma unroll
        for (int j = 0; j < 4; ++j) { const float o = S.O1[dt][j] * i1 - S.O2[dt][j] * i2; S.O1[dt][j] = o; ss += o * o; }
    ss += __shfl_xor(ss, 16); ss += __shfl_xor(ss, 32);
    const float rs = (1.f - lam_init) / sqrtf(ss * (1.f / 64.f) + EPS);
    bf16* op = MIX + (size_t)(qrow0 + qr + fr) * DM + 256 + h * 64 + 4 * fq;
#pragma unroll
    for (int dt = 0; dt < 4; ++dt) { const f32x4 gn = *(const f32x4*)(a.in[I_DNORM] + l * 64 + 16 * dt + 4 * fq);
        u32x2 w; w.x = pk2(S.O1[dt][0] * rs * gn[0], S.O1[dt][1] * rs * gn[1]); w.y = pk2(S.O1[dt][2] * rs * gn[2], S.O1[dt][3] * rs * gn[3]);
        *(u32x2*)(op + 16 * dt) = w; }
}
constexpr int AT_UNITS = 576;
template <int VAR>
DI void attn_unit(const Args& a, const Frame& F, int l, int unit) {
    if (unit >= 112 && unit < 176) { const int u = unit - 112, b = u >> 1, hp = u & 1;
        attn_segment<VAR>(a, F, l, NP + b * 64, PAST, hp, 33, 32, a.in[I_CK] + (size_t)(l * BS + b) * PAST * 256, a.in[I_CV] + (size_t)(l * BS + b) * PAST * 256, NP + b * 64);
    } else { const int u = unit < 112 ? unit : unit - 64, c = 63 - (u >> 3), b = (u >> 1) & 3, hp = u & 1;
        attn_segment<VAR>(a, F, l, b * TP + c * 64, c * 64, hp, c + 1, 0, nullptr, nullptr, b * TP);
    }
}

constexpr int XA_K = 0, XA_V = 69632;
DI void xattn_unit(const Args& a, const Frame& F, int l, int unit) {
    const bf16* Q = (const bf16*)(a.ws + WS_Q); bf16* OX = (bf16*)(a.ws + WS_OX);
    int lane = F.lane, tid = F.tid; asm volatile("" : "+v"(lane), "+v"(tid));
    const int fr = lane & 15, fq = lane >> 4;
    const bool prompt = unit < 128;
    int b, h, row0, nrg;
    if (prompt) { b = unit >> 5; h = (unit >> 3) & 3; row0 = b * TP + (unit & 7) * 512; nrg = 32; }
    else { const int u = unit - 128; b = u >> 2; h = u & 3; row0 = NP + b * 64; nrg = 4; }
    bf16x8 qfa[4][4];
#pragma unroll
    for (int rr = 0; rr < 4; ++rr) { const int rg = F.wave + rr * NWAVES; const int row = row0 + 16 * (rg < nrg ? rg : 0) + fr;
#pragma unroll
        for (int ks = 0; ks < 4; ++ks) qfa[rr][ks] = ld8g(Q + (size_t)row * XW + h * 128 + 32 * ks + 8 * fq); }
    if (prompt) {
        const bf16* kb = (const bf16*)(a.ws + WS_MK) + ((size_t)l * (BP * NMEM) + b * NMEM) * XW + h * 128; const bf16* vb = (const bf16*)(a.ws + WS_MV) + ((size_t)l * (BP * NMEM) + b * NMEM) * XW + h * 128;
        u32x4 kr[8], vr[8];
#pragma unroll
        for (int i = 0; i < 8; ++i) { const int e = tid + i * NTHR, key = e >> 4, c8 = (e & 15) * 8; kr[i] = *(const u32x4*)(kb + (size_t)key * XW + c8); vr[i] = *(const u32x4*)(vb + (size_t)key * XW + c8); }
#pragma unroll
        for (int i = 0; i < 8; ++i) { const int e = tid + i * NTHR, key = e >> 4, c8 = (e & 15) * 8;
            *(LAS u32x4*)(F.lds + XA_K + key * 272 + c8 * 2) = kr[i]; *(LAS u32x4*)(F.lds + XA_V + key * 288 + c8 * 2) = vr[i]; }
    } else {
        const float* kb = a.in[I_CMK] + ((size_t)(l * BS + b) * NMEM * 4 + h) * 128; const float* vb = a.in[I_CMV] + ((size_t)(l * BS + b) * NMEM * 4 + h) * 128;
#pragma unroll
        for (int hb = 0; hb < 2; ++hb) {
            f32x4 kr[4][2], vr[4][2];
#pragma unroll
            for (int i = 0; i < 4; ++i) { const int e = tid + (hb * 4 + i) * NTHR, key = e >> 4, c8 = (e & 15) * 8; const f32x4* k4 = (const f32x4*)(kb + (size_t)key * 512 + c8); const f32x4* v4 = (const f32x4*)(vb + (size_t)key * 512 + c8);
                kr[i][0] = k4[0]; kr[i][1] = k4[1]; vr[i][0] = v4[0]; vr[i][1] = v4[1]; }
#pragma unroll
            for (int i = 0; i < 4; ++i) { const int e = tid + (hb * 4 + i) * NTHR, key = e >> 4, c8 = (e & 15) * 8;
                *(LAS u32x4*)(F.lds + XA_K + key * 272 + c8 * 2) = pack8(kr[i][0], kr[i][1]); *(LAS u32x4*)(F.lds + XA_V + key * 288 + c8 * 2) = pack8(vr[i][0], vr[i][1]); }
        }
    }
    __syncthreads();
#pragma unroll
    for (int pr = 0; pr < 2; ++pr) {
        const int rgA = F.wave + (2 * pr) * NWAVES, rgB = rgA + NWAVES; if (rgA >= nrg) break;
        const bool hasB = rgB < nrg;
        const int rowA = row0 + 16 * rgA + fr, rowB = row0 + 16 * (hasB ? rgB : rgA) + fr;
        float mA = -1e30f, lA = 0.f, mB = -1e30f, lB = 0.f;
        f32x4 OA[8], OB[8];
#pragma unroll
        for (int dt = 0; dt < 8; ++dt) { OA[dt] = (f32x4){0.f, 0.f, 0.f, 0.f}; OB[dt] = (f32x4){0.f, 0.f, 0.f, 0.f}; }
#pragma unroll 1
        for (int s8 = 0; s8 < 8; ++s8) {
            f32x4 a0 = (f32x4){0.f, 0.f, 0.f, 0.f}, a1 = a0, b0 = a0, b1 = a0;
#pragma unroll
            for (int ks = 0; ks < 4; ++ks) { const LAS unsigned char* kr = F.lds + XA_K + (32 * s8 + fr) * 272 + (32 * ks + 8 * fq) * 2;
                const bf16x8 k0 = ld8l(kr), k1 = ld8l(kr + 16 * 272);
                a0 = MFMA16(k0, qfa[2 * pr][ks], a0); a1 = MFMA16(k1, qfa[2 * pr][ks], a1); b0 = MFMA16(k0, qfa[2 * pr + 1][ks], b0); b1 = MFMA16(k1, qfa[2 * pr + 1][ks], b1); }
            float mxA = fmaxf(fmaxf(fmaxf(a0[0], a0[1]), fmaxf(a0[2], a0[3])), fmaxf(fmaxf(a1[0], a1[1]), fmaxf(a1[2], a1[3])));
            float mxB = fmaxf(fmaxf(fmaxf(b0[0], b0[1]), fmaxf(b0[2], b0[3])), fmaxf(fmaxf(b1[0], b1[1]), fmaxf(b1[2], b1[3])));
            mxA = fmaxf(mxA, __shfl_xor(mxA, 16)); mxB = fmaxf(mxB, __shfl_xor(mxB, 16)); mxA = fmaxf(mxA, __shfl_xor(mxA, 32)); mxB = fmaxf(mxB, __shfl_xor(mxB, 32));
            const float mnA = fmaxf(mA, mxA), alA = fast_exp2(mA - mnA), mnB = fmaxf(mB, mxB), alB = fast_exp2(mB - mnB); mA = mnA; mB = mnB;
            float psA = 0.f, psB = 0.f;
#pragma unroll
            for (int j = 0; j < 4; ++j) { a0[j] = fast_exp2(a0[j] - mnA); a1[j] = fast_exp2(a1[j] - mnA); psA += a0[j] + a1[j]; b0[j] = fast_exp2(b0[j] - mnB); b1[j] = fast_exp2(b1[j] - mnB); psB += b0[j] + b1[j]; }
            lA = lA * alA + psA; lB = lB * alB + psB;
            const bf16x8 pfA = packp(a0, a1), pfB = packp(b0, b1);
#pragma unroll
            for (int dt = 0; dt < 8; ++dt) { const LAS unsigned char* vr = F.lds + XA_V + (32 * s8 + 4 * fq + (fr >> 2)) * 288 + (16 * dt + 4 * (fr & 3)) * 2;
                const bf16x8 vt = cat44(tr4(vr), tr4(vr + 16 * 288));
                OA[dt] = MFMA16(vt, pfA, OA[dt] * alA); OB[dt] = MFMA16(vt, pfB, OB[dt] * alB); }
        }
        lA += __shfl_xor(lA, 16); lA += __shfl_xor(lA, 32); lB += __shfl_xor(lB, 16); lB += __shfl_xor(lB, 32);
        const float invA = 1.f / lA, invB = 1.f / lB;
        bf16* opA = OX + (size_t)rowA * XW + h * 128 + 4 * fq; bf16* opB = OX + (size_t)rowB * XW + h * 128 + 4 * fq;
#pragma unroll
        for (int dt = 0; dt < 8; ++dt) { const f32x4 o = OA[dt]; u32x2 w; w.x = pk2(o[0] * invA, o[1] * invA); w.y = pk2(o[2] * invA, o[3] * invA); *(u32x2*)(opA + 16 * dt) = w; }
        if (hasB) {
#pragma unroll
            for (int dt = 0; dt < 8; ++dt) { const f32x4 o = OB[dt]; u32x2 w; w.x = pk2(o[0] * invB, o[1] * invB); w.y = pk2(o[2] * invB, o[3] * invB); *(u32x2*)(opB + 16 * dt) = w; }
        }
    }
}
constexpr int PH_PER_LAYER = 15, PH_FINAL = 1 + DEPTH * PH_PER_LAYER, N_PHASES = PH_FINAL + 1;
#ifndef PHMASK
#define PHMASK 0xFFFF
#endif
#define PH_ON(k) (((PHMASK) >> (k)) & 1)
#ifndef PROBE_PMODE
#define PROBE_PMODE 0
#endif
#ifndef REPMASK
#define REPMASK 0
#endif
#define REPS(k) ((((REPMASK) >> (k)) & 1) ? 2 : 1)
#define REPBAR(k) do { if (rep + 1 < REPS(k)) xcd_barrier(bar); } while (0)
#ifndef MK_MULTI
#define MK_MULTI 0
#endif

DI void launder(Frame& F) { asm volatile("" : "+v"(F.tid), "+v"(F.lane)); asm volatile("" : "+s"(F.wave), "+s"(F.bid)); }
#define LAUNDER() do { launder(F); GAS unsigned char* _g = (GAS unsigned char*)ws; asm volatile("" : "+s"(_g)); ws = (unsigned char*)_g; } while (0)
__global__ void __launch_bounds__(NTHR, 2) fwd(Args args) {
    extern __shared__ __attribute__((aligned(16))) unsigned char lds_raw[];
    Frame F;
    F.lds = (LAS unsigned char*)lds_raw;
    F.MISC = (volatile LAS unsigned*)(F.lds + LDSCTL_OFF);
    F.tid = threadIdx.x; F.lane = F.tid & 63; F.wave = __builtin_amdgcn_readfirstlane(F.tid >> 6);
    F.G = gridDim.x; F.bid = blockIdx.x;
    F.ctl = (gu32*)(args.ws + WS_CTL);
    if (F.tid < 64) F.MISC[F.tid] = 0u;
    __syncthreads();
    XcdBarrier bar; bar.bar = (unsigned*)(F.ctl + CW_BAR); bar.x = 0; bar.st = nullptr;
    if (!MK_MULTI) bar = xcd_barrier_post((unsigned*)(F.ctl + CW_BAR), F.MISC + 8);
    const int lo = args.ph_lo, hi = args.ph_hi;
#define IN(k) (lo <= (k) && (k) < hi)
#define SEAM(k) do { if (IN(k) && IN((k) + 1)) xcd_barrier(bar); } while (0)
    unsigned char* ws = args.ws;
#define X ((float*)(ws + WS_X))
#define RSITE(k) ((float*)(ws + WS_RSTD) + (size_t)(k) * MT)
#define PSITE(k) ((float*)(ws + WS_SSP) + (size_t)(k) * MT * 16)
#define RS_LDS ((const LAS float*)(F.lds + LDS_RS))

    if (PH_ON(0) && IN(0)) for (int rep = 0; rep < REPS(0); ++rep) { LAUNDER(); prologue_weights(args, F, rep ? PROBE_PMODE : 0); if (rep == 0 || PROBE_PMODE == 0) { prologue_tables(args, F); memnorm_phase(args, F); } REPBAR(0); }
    SEAM(0);

    for (int l = 0; l < DEPTH; ++l) {
        const int pb = 1 + l * PH_PER_LAYER;
#define wl (ws + WS_W + (size_t)l * LW)
        if (PH_ON(1) && IN(pb + 0)) for (int rep = 0; rep < REPS(1); ++rep) { LAUNDER(); if (l == 0) norm_phase<1>(args, F, 0, 0.f, RSITE(0), nullptr); else norm_phase<0>(args, F, rep ? 0 : 8, 0.5f, RSITE(4 * l), PSITE(4 * l)); REPBAR(1); }
        SEAM(pb + 0);
        if (PH_ON(2) && IN(pb + 1)) for (int rep = 0; rep < REPS(2); ++rep) { LAUNDER(); pg8::Sched S{(const char*)(ws + WS_X), (const char*)(wl + W_GU1), DM, DM, MT / 256, 2 * DFF / 256, DM / 64, F.G, F.bid, nullptr, nullptr, 0, 0, 0, 0, 0};
            fill_rs_table(F, S, RSITE(4 * l)); EpiSwiGLU E{(bf16*)(ws + WS_ACT), RS_LDS}; pg8::gemm_phase<EpiSwiGLU, true>(F.lds, S, E, F.tid); REPBAR(2); }
        SEAM(pb + 1);
        if (PH_ON(3) && IN(pb + 2)) for (int rep = 0; rep < (REPS(3) > REPS(16) ? REPS(3) : REPS(16)); ++rep) { LAUNDER(); pg8::Sched S{(const char*)(ws + WS_ACT), (const char*)(wl + W_D1), ALD, ALD, NP / 256, DM / 256, DFF / 64, F.G, F.bid,
                                       (const char*)(ws + WS_ACT) + (size_t)NP * ALD * 2, (const char*)(wl + W_D1), NP / 256, (rep && REPS(20) > 1) ? 0 : NS / 256, DM / 256, 8, DFF / 64 / 8};
            EpiResid E{ws, rep ? 0.f : 0.5f, rep ? 16 : 4 * l + 1}; pg8::gemm_phase<EpiResid, true>(F.lds, S, E, F.tid); do { if (rep == 0 && (REPMASK & 0xF0008)) xcd_barrier(bar); } while (0); }
        SEAM(pb + 2);
        if (PH_ON(1) && IN(pb + 3)) for (int rep = 0; rep < REPS(1); ++rep) { LAUNDER(); norm_phase<0>(args, F, rep ? 0 : 8, 0.5f, RSITE(4 * l + 1), PSITE(4 * l + 1)); REPBAR(1); }
        SEAM(pb + 3);
#define WIN_EPI EpiWin E{(bf16*)(ws + WS_P), args.out + O_PK + (size_t)l * NP * 256, args.out + O_PV + (size_t)l * NP * 256, args.out + O_SK + (size_t)l * NS * 256, args.out + O_SV + (size_t)l * NS * 256, \
                     args.out + O_PMK + (size_t)l * BP * NMEM * XW, args.out + O_PMV + (size_t)l * BP * NMEM * XW, \
                     (bf16*)(ws + WS_MK) + (size_t)l * BP * NMEM * XW, (bf16*)(ws + WS_MV) + (size_t)l * BP * NMEM * XW, RS_LDS}
        if (PH_ON(4) && IN(pb + 4)) for (int rep = 0; rep < REPS(4); ++rep) { LAUNDER(); pg8::Sched S{(const char*)(ws + WS_X), (const char*)(wl + W_IN), DM, DM, MT / 256, INW / 256 - 1, DM / 64, F.G, F.bid, nullptr, nullptr, 0, 0, 0, 0, 0, 0};
            WIN_EPI; fill_rs_table(F, S, RSITE(4 * l + 1)); pg8::gemm_phase<EpiWin, true>(F.lds, S, E, F.tid); REPBAR(4); }
        SEAM(pb + 4);
        if (IN(pb + 5)) {
            if (PH_ON(4)) { LAUNDER(); pg8::Sched S{(const char*)(ws + WS_X), (const char*)(wl + W_IN), DM, DM, MT / 256, 1, DM / 64, F.G, F.G - 1 - F.bid,
                                       (const char*)(ws + WS_MEMN), (const char*)(ws + WS_WKV) + (size_t)l * 1024 * DM * 2, 0, 4, 4, 1, DM / 64, INW / 256 - 1};
                WIN_EPI; fill_rs_table(F, S, RSITE(4 * l + 1)); pg8::gemm_phase<EpiWin, true>(F.lds, S, E, F.tid); }
            const unsigned at_nx = (unsigned)__builtin_amdgcn_readfirstlane((int)F.MISC[9]), at_rk = (unsigned)__builtin_amdgcn_readfirstlane((int)F.MISC[10]); gu32* at_ctr = F.ctl + CW_CNTX + 64 * (l * 16 + (int)at_rk);
            const unsigned at_t0 = deal_prefetch(F, at_ctr);
            LAUNDER(); if (PH_ON(5)) ssm_pass1(args, F, l);
            signal_done_release(F, cnt_word(F, l, CNT_SSM1DONE));
#ifndef ATTN_VAR
#define ATTN_VAR 0
#endif
            if (ATTN_VAR) { LAUNDER(); DEAL_LOOP(F, cnt_word(F, l, CNT_ATTN + 5), AT_UNITS, attn_unit<ATTN_VAR>(args, F, l, u)); xcd_barrier(bar); }
            { LAUNDER(); const int nj = (AT_UNITS - (int)at_rk + (int)at_nx - 1) / (int)at_nx;
              int j = deal_publish(F, at_t0);
              while (j < nj) { const unsigned _t = deal_prefetch(F, at_ctr); attn_unit<0>(args, F, l, j * (int)at_nx + (int)at_rk); j = deal_publish(F, _t); }
              __syncthreads(); }
            wait_done(F, cnt_word(F, l, CNT_SSM1DONE), (unsigned)F.G);
            for (int rep = 0; rep < REPS(9); ++rep) { LAUNDER();
                if (PH_ON(9)) DEAL_LOOP_DYN(F, cnt_word(F, l, CNT_SSM2 + 5 * rep), 288, ssm_pass2_unit(args, F, l, u));
                REPBAR(9); }
            for (int rep = 0; rep < REPS(6); ++rep) { LAUNDER();
                if (PH_ON(6)) DEAL_LOOP_DYN(F, cnt_word(F, l, CNT_CONV + 5 * rep), 288, conv_unit(args, F, l, u));
                REPBAR(6); }
            for (int rep = 0; rep < REPS(7); ++rep) { LAUNDER();
                if (PH_ON(7)) DEAL_LOOP_DYN(F, cnt_word(F, l, CNT_GMLP + 5 * rep), 160, gmlp_unit(args, F, l, u));
                REPBAR(7); }
            { LAUNDER(); const int cv0 = BT_EARLY + l * BT_LAYER, cvn = ((l + 1 < DEPTH ? BT_LAYER : BT_LAYER - BT_EARLY)) / CV_PER;
              DEAL_LOOP_DYN(F, cnt_word(F, l, CNT_CVT), cvn, cvt_unit(args, F, cv0 + u * CV_PER)); }
        }
        SEAM(pb + 5);
        if (PH_ON(3) && IN(pb + 7)) for (int rep = 0; rep < (REPS(3) > REPS(17) ? REPS(3) : REPS(17)); ++rep) { LAUNDER(); pg8::Sched S{(const char*)(ws + WS_MIX), (const char*)(wl + W_OUT), DM, DM, NP / 256, DM / 256, DM / 64, F.G, F.bid,
                                       (const char*)(ws + WS_MIX) + (size_t)NP * DM * 2, (const char*)(wl + W_OUT), NP / 256, (rep && REPS(20) > 1) ? 0 : NS / 256, DM / 256, 4, DM / 64 / 4};
            EpiResid E{ws, rep ? 0.f : 1.f, rep ? 16 : 4 * l + 2}; pg8::gemm_phase<EpiResid, true>(F.lds, S, E, F.tid); do { if (rep == 0 && (REPMASK & 0xF0008)) xcd_barrier(bar); } while (0); }
        SEAM(pb + 7);
        if (PH_ON(1) && IN(pb + 8)) for (int rep = 0; rep < REPS(1); ++rep) { LAUNDER(); norm_phase<0>(args, F, rep ? 0 : 4, 1.f, RSITE(4 * l + 2), PSITE(4 * l + 2)); REPBAR(1); }
        SEAM(pb + 8);
        if (PH_ON(10) && IN(pb + 9)) for (int rep = 0; rep < REPS(10); ++rep) { LAUNDER(); pg8::Sched S{(const char*)(ws + WS_X), (const char*)(wl + W_Q), DM, DM, MT / 256, XW / 256, DM / 64, F.G, F.bid, nullptr, nullptr, 0, 0, 0, 0, 0};
            fill_rs_table(F, S, RSITE(4 * l + 2)); EpiQ E{(bf16*)(ws + WS_Q), RS_LDS}; pg8::gemm_phase<EpiQ, true>(F.lds, S, E, F.tid); REPBAR(10); }
        SEAM(pb + 9);
        if (PH_ON(11) && IN(pb + 10)) for (int rep = 0; rep < REPS(11); ++rep) { LAUNDER(); DEAL_LOOP(F, cnt_word(F, l, CNT_XATTN + 5 * rep), 256, xattn_unit(args, F, l, u)); REPBAR(11); }
        SEAM(pb + 10);
        if (PH_ON(3) && IN(pb + 11)) for (int rep = 0; rep < (REPS(3) > REPS(18) ? REPS(3) : REPS(18)); ++rep) { LAUNDER(); pg8::Sched S{(const char*)(ws + WS_OX), (const char*)(wl + W_O), XW, XW, NP / 256, DM / 256, XW / 64, F.G, F.bid,
                                        (const char*)(ws + WS_OX) + (size_t)NP * XW * 2, (const char*)(wl + W_O), NP / 256, (rep && REPS(20) > 1) ? 0 : NS / 256, DM / 256, 2, XW / 64 / 2};
            EpiResid E{ws, rep ? 0.f : 1.f, rep ? 16 : 4 * l + 3}; pg8::gemm_phase<EpiResid, true>(F.lds, S, E, F.tid); do { if (rep == 0 && (REPMASK & 0xF0008)) xcd_barrier(bar); } while (0); }
        SEAM(pb + 11);
        if (PH_ON(1) && IN(pb + 12)) for (int rep = 0; rep < REPS(1); ++rep) { LAUNDER(); norm_phase<0>(args, F, rep ? 0 : 2, 1.f, RSITE(4 * l + 3), PSITE(4 * l + 3)); REPBAR(1); }
        SEAM(pb + 12);
        if (PH_ON(2) && IN(pb + 13)) for (int rep = 0; rep < REPS(2); ++rep) { LAUNDER(); pg8::Sched S{(const char*)(ws + WS_X), (const char*)(wl + W_GU2), DM, DM, MT / 256, 2 * DFF / 256, DM / 64, F.G, F.bid, nullptr, nullptr, 0, 0, 0, 0, 0};
            fill_rs_table(F, S, RSITE(4 * l + 3)); EpiSwiGLU E{(bf16*)(ws + WS_ACT), RS_LDS}; pg8::gemm_phase<EpiSwiGLU, true>(F.lds, S, E, F.tid); REPBAR(2); }
        SEAM(pb + 13);
        if (PH_ON(3) && IN(pb + 14)) for (int rep = 0; rep < (REPS(3) > REPS(19) ? REPS(3) : REPS(19)); ++rep) { LAUNDER(); pg8::Sched S{(const char*)(ws + WS_ACT), (const char*)(wl + W_D2), ALD, ALD, NP / 256, DM / 256, DFF / 64, F.G, F.bid,
                                        (const char*)(ws + WS_ACT) + (size_t)NP * ALD * 2, (const char*)(wl + W_D2), NP / 256, (rep && REPS(20) > 1) ? 0 : NS / 256, DM / 256, 8, DFF / 64 / 8};
            EpiResid E{ws, rep ? 0.f : 0.5f, rep ? 16 : 4 * l + 4}; pg8::gemm_phase<EpiResid, true>(F.lds, S, E, F.tid); do { if (rep == 0 && (REPMASK & 0xF0008)) xcd_barrier(bar); } while (0); }
        SEAM(pb + 14);
    }
#undef wl
    if (PH_ON(12) && IN(PH_FINAL)) { LAUNDER(); norm_phase<2>(args, F, 8, 0.5f, nullptr, nullptr); }
#undef IN
#undef SEAM
#undef X
#undef RSITE
#undef PSITE
#undef RS_LDS
}

extern "C" void kernel_launch(void* const* d_in, const int* in_sizes, int n_in, void* d_out, int out_size, void* d_ws, size_t ws_size, hipStream_t stream) {
    static int grid = 0;
    if (grid == 0) {
        if (n_in != N_IN || (size_t)out_size != O_END || ws_size < WS_END) { fprintf(stderr, "kernel_launch: unexpected shapes: n_in %d out %d (want %zu) ws %zu (want %zu); nothing launched\n", n_in, out_size, (size_t)O_END, ws_size, (size_t)WS_END); grid = -1; return; }
        int dev = 0, cus = 0, per_cu = 0;
        if (hipGetDevice(&dev) != hipSuccess || hipDeviceGetAttribute(&cus, hipDeviceAttributeMultiprocessorCount, dev) != hipSuccess) { grid = -1; return; }
        if (hipFuncSetAttribute((const void*)fwd, hipFuncAttributeMaxDynamicSharedMemorySize, LDS_BYTES) != hipSuccess) { fprintf(stderr, "kernel_launch: hipFuncSetAttribute failed\n"); grid = -1; return; }
        if (hipOccupancyMaxActiveBlocksPerMultiprocessor(&per_cu, (const void*)fwd, NTHR, LDS_BYTES) != hipSuccess || per_cu < 1) fprintf(stderr, "kernel_launch: occupancy query reports %d blocks per CU\n", per_cu);
        (void)hipGetLastError();
        grid = cus;
    }
    if (grid < 0) return;
    (void)hipMemsetAsync((char*)d_ws + WS_CTL, 0, CTL_ZERO_BYTES, stream);
    Args a{};
    for (int i = 0; i < N_IN; ++i) a.in[i] = (const float*)d_in[i];
    a.out = (float*)d_out; a.ws = (unsigned char*)d_ws;
#if MK_MULTI
    for (int p = 0; p < N_PHASES; ++p) { a.ph_lo = p; a.ph_hi = p + 1; hipLaunchKernelGGL(fwd, dim3(grid), dim3(NTHR), LDS_BYTES, stream, a); }
#else
    a.ph_lo = 0; a.ph_hi = N_PHASES;
    hipLaunchKernelGGL(fwd, dim3(grid), dim3(NTHR), LDS_BYTES, stream, a);
#endif
    const hipError_t le = hipPeekAtLastError();
    if (le != hipSuccess) fprintf(stderr, "kernel_launch: launch failed: %s\n", hipGetErrorName(le));
}
```

```cpp
#include <hip/hip_runtime.h>
#include <cstdio>
#include <cstdint>

#define GAS __attribute__((address_space(1)))
#define LAS __attribute__((address_space(3)))
typedef unsigned short bf16;
typedef unsigned u32x4 __attribute__((ext_vector_type(4)));
typedef unsigned u32x2 __attribute__((ext_vector_type(2)));
typedef float f32x4 __attribute__((ext_vector_type(4)));
typedef float f32x2 __attribute__((ext_vector_type(2)));
typedef short bf16x8 __attribute__((ext_vector_type(8)));
typedef short s16x4 __attribute__((ext_vector_type(4)));
typedef GAS unsigned gu32;
#define DI __device__ __forceinline__

constexpr int DM = 1024, DEPTH = 4, DFF = 4096, INW = 2048, XW = 512;
constexpr int BP = 4, TP = 4096, BS = 32, TS = 64, PAST = 2048, NMEM = 256;
constexpr int NP = BP * TP, NS = BS * TS, MT = NP + NS;
constexpr float EPS = 1e-6f;
constexpr float LOG2E = 1.4426950408889634f;

constexpr size_t MiB = 1u << 20, KiB = 1024;
constexpr size_t WS_CTL = 0, CTL_ZERO_BYTES = 128 * KiB;
constexpr size_t WS_W = 1 * MiB, LW = 59 * MiB;
constexpr size_t W_GU1 = 0, W_D1 = 16 * MiB, W_IN = 25 * MiB, W_OUT = 29 * MiB, W_Q = 31 * MiB, W_O = 32 * MiB, W_GU2 = 33 * MiB, W_D2 = 49 * MiB, W_SMALL = 58 * MiB;
constexpr int ALD = DFF + 64;
constexpr size_t S_WGLU = 0, S_WPW = 128 * KiB, S_GMLPW = 256 * KiB, S_BBART = 384 * KiB, S_CMT = 448 * KiB, S_AB = 512 * KiB, S_A64 = 520 * KiB, S_A256 = 528 * KiB, S_LAM = 536 * KiB;
constexpr size_t WS_WKV = WS_W + 4 * LW;
constexpr size_t WS_MEMN = WS_WKV + 8 * MiB;
constexpr size_t WS_MK = WS_MEMN + 2 * MiB, WS_MV = WS_MK + 4 * MiB;
constexpr size_t WS_X = WS_MV + 4 * MiB;
constexpr size_t WS_XN = WS_X + 72 * MiB;
constexpr size_t WS_ACT = WS_XN + 36 * MiB;
constexpr size_t WS_P = WS_ACT, WS_MIX = WS_ACT + 72 * MiB, WS_Q = WS_ACT + 108 * MiB, WS_OX = WS_ACT + 126 * MiB;
constexpr size_t WS_SLAB = WS_ACT + 148 * MiB;
constexpr size_t WS_SSME = WS_SLAB + 64 * MiB;
constexpr size_t WS_SSP = WS_SSME + 2 * MiB;
constexpr size_t WS_RSTD = WS_SSP + 21 * MiB;
constexpr size_t WS_END = WS_RSTD + 2 * MiB;

constexpr int CW_TMO = 0, CW_BAR = 4096, CW_CNT = 16384;

constexpr size_t O_YP = 0, O_YS = O_YP + (size_t)NP * DM, O_PK = O_YS + (size_t)NS * DM, O_PV = O_PK + (size_t)DEPTH * NP * 256,
                 O_PSR = O_PV + (size_t)DEPTH * NP * 256, O_PSI = O_PSR + DEPTH * BP * 1024, O_PCV = O_PSI + DEPTH * BP * 1024,
                 O_PMK = O_PCV + DEPTH * BP * 30 * 256, O_PMV = O_PMK + (size_t)DEPTH * BP * NMEM * XW, O_SK = O_PMV + (size_t)DEPTH * BP * NMEM * XW,
                 O_SV = O_SK + (size_t)DEPTH * NS * 256, O_SSR = O_SV + (size_t)DEPTH * NS * 256, O_SSI = O_SSR + DEPTH * BS * 1024,
                 O_SCV = O_SSI + DEPTH * BS * 1024, O_SGV = O_SCV + DEPTH * BS * 30 * 256, O_END = O_SGV + (size_t)DEPTH * NS * 256;

enum { I_XP = 0, I_XS, I_MEM, I_CK, I_CV, I_SRE, I_SIM, I_SCONV, I_CMK, I_CMV, I_F1N, I_F1G, I_F1U, I_F1D, I_MIXN, I_WIN, I_WOUT,
       I_AR, I_AI, I_BR, I_BI, I_CR, I_CI, I_SD, I_LDT, I_WGLU, I_BGLU, I_LQ1, I_LK1, I_LQ2, I_LK2, I_DNORM,
       I_CW, I_CB, I_CLG, I_CLB, I_CPW, I_GLG, I_GLB, I_GWS, I_GBS, I_XN, I_MEMNORM, I_XWQ, I_XWK, I_XWV, I_XWO,
       I_F2N, I_F2G, I_F2U, I_F2D, I_FINAL, N_IN };

constexpr int LDS_BYTES = 163840, LDS_MAIN = 159744, LDSCTL_OFF = LDS_MAIN, LDS_RS = 131072;
constexpr int NWAVES = 8, NTHR = 512;

#define RLX_AGENT __ATOMIC_RELAXED, __HIP_MEMORY_SCOPE_AGENT
#define LDS_WAIT() asm volatile("s_waitcnt lgkmcnt(0)" ::: "memory")
#define VM_WAIT() asm volatile("s_waitcnt vmcnt(0)" ::: "memory")
typedef __bf16 hwbf16x2 __attribute__((ext_vector_type(2)));
DI unsigned pk2(float lo, float hi) { const f32x2 v = {lo, hi}; return __builtin_bit_cast(unsigned, __builtin_convertvector(v, hwbf16x2)); }
DI unsigned f2bf(float f) { return pk2(f, f) & 0xffffu; }
DI float bf2f(unsigned short b) { return __builtin_bit_cast(float, (unsigned)b << 16); }
DI float bflo(unsigned w) { return __builtin_bit_cast(float, w << 16); }
DI float bfhi(unsigned w) { return __builtin_bit_cast(float, w & 0xffff0000u); }
DI float fast_exp2(float x) { return __builtin_amdgcn_exp2f(x); }
DI float fast_rcp(float x) { return __builtin_amdgcn_rcpf(x); }
DI float sigmoidf_(float x) { return fast_rcp(1.f + fast_exp2(-LOG2E * x)); }
DI float siluf_(float x) { return x * sigmoidf_(x); }
DI float gelu_tanh(float x) { const float z = 0.7978845608028654f * (x + 0.044715f * x * x * x); return x * fast_rcp(1.f + fast_exp2(-2.f * LOG2E * z)); }
template <int N> DI void wave_sum_n(float (&v)[N]) {
#pragma unroll
    for (int o = 1; o < 64; o <<= 1) {
        float t[N];
#pragma unroll
        for (int i = 0; i < N; ++i) t[i] = __shfl_xor(v[i], o);
#pragma unroll
        for (int i = 0; i < N; ++i) v[i] += t[i]; }
}
DI float wave_sum(float v) {
#pragma unroll
    for (int o = 1; o < 64; o <<= 1) v += __shfl_xor(v, o);
    return v;
}

#define XB_TMO      128
#define XB_XCNT(j)  (256  + 64 * (j))
#define XB_XSUB(j)  (1280 + 64 * (j))
#define XB_XGEN(j)  (2304 + 64 * (j))
#define XB_TOP      3328
#define XB_TOPGEN   3392
#define XCD_BAR_WORDS 3456
#define XB_SPIN_CAP (1u << 18)
DI unsigned xb_ld(unsigned* p)              { return __hip_atomic_load(p, __ATOMIC_RELAXED, __HIP_MEMORY_SCOPE_AGENT); }
DI unsigned xb_add(unsigned* p, unsigned v) { return __hip_atomic_fetch_add(p, v, __ATOMIC_RELAXED, __HIP_MEMORY_SCOPE_AGENT); }
DI unsigned xb_xcc_id() { return (unsigned)__builtin_amdgcn_s_getreg((3 << 11) | 20) & 0xFu; }
#define XB_SPIN(cond, bar) do { unsigned _sp = 0; while (cond) { __builtin_amdgcn_s_sleep(1); \
    if ((++_sp & 255u) == 0u) { if (xb_ld(&(bar)[XB_TMO])) break; if (_sp > XB_SPIN_CAP) { atomicAdd(&(bar)[XB_TMO], 1u); break; } } } } while (0)
struct XcdBarrier { unsigned* bar; unsigned x; volatile LAS unsigned* st; };
DI XcdBarrier xcd_barrier_post(unsigned* bar, volatile LAS unsigned* st) {
    XcdBarrier b; b.bar = bar; b.x = xb_xcc_id(); b.st = st;
    if (threadIdx.x == 0) (void)xb_add(&bar[XB_XCNT(b.x)], 1u);
    return b;
}
DI void xcd_barrier_complete(unsigned* bar, unsigned x, unsigned& nloc, unsigned& nx) {
    const unsigned G = gridDim.x * gridDim.y * gridDim.z;
    unsigned sum, cnt, mine, sp = 0u;
    for (;;) {
        sum = 0u; cnt = 0u; mine = 0u;
#pragma unroll
        for (unsigned j = 0; j < 16; ++j) { const unsigned c = xb_ld(&bar[XB_XCNT(j)]); sum += c; cnt += (c > 0u) ? 1u : 0u; mine = (j == x) ? c : mine; }
        if (sum == G) break;
        __builtin_amdgcn_s_sleep(1);
        if ((++sp & 255u) == 0u) { if (xb_ld(&bar[XB_TMO])) break; if (sp > XB_SPIN_CAP) { atomicAdd(&bar[XB_TMO], 1u); break; } }
    }
    nloc = mine > 0u ? mine : 1u; nx = cnt > 0u ? cnt : 1u;
}
DI void xcd_barrier(const XcdBarrier& b) {
    asm volatile("s_waitcnt vmcnt(0)" ::: "memory");
    __syncthreads();
    if (threadIdx.x == 0) {
        unsigned* bar = b.bar;
        __builtin_amdgcn_s_waitcnt(0);
        unsigned nloc = b.st[0], nx = b.st[1];
        if (nloc == 0u) { xcd_barrier_complete(bar, b.x, nloc, nx); b.st[0] = nloc; b.st[1] = nx; }
        const unsigned old = xb_add(&bar[XB_XSUB(b.x)], 1u);
        const unsigned gen = old / nloc;
        if (old + 1u == (gen + 1u) * nloc) {
            __builtin_amdgcn_fence(__ATOMIC_RELEASE, "agent");
            asm volatile("s_waitcnt vmcnt(0)" ::: "memory");
            const unsigned og = xb_add(&bar[XB_TOP], 1u);
            const unsigned tg = og / nx;
            if (og + 1u == (tg + 1u) * nx) xb_add(&bar[XB_TOPGEN], 1u);
            else XB_SPIN(xb_ld(&bar[XB_TOPGEN]) == tg, bar);
            __builtin_amdgcn_fence(__ATOMIC_ACQUIRE, "agent");
            xb_add(&bar[XB_XGEN(b.x)], 1u);
            asm volatile("s_waitcnt vmcnt(0)" ::: "memory");
        } else {
            XB_SPIN(xb_ld(&bar[XB_XGEN(b.x)]) == gen, bar);
            __builtin_amdgcn_fence(__ATOMIC_ACQUIRE, "agent");
            asm volatile("s_waitcnt vmcnt(0)" ::: "memory");
        }
    }
    __syncthreads();
}

namespace pg8 {
constexpr int BM = 256, BK = 64, HALF = 128, HTB = HALF * BK * 2, STAGE_BYTES = 8 * HTB;
__host__ __device__ __forceinline__ int lds_byte(int r, int c) { const int st = (r >> 4) * 2 + (c >> 5), rr = r & 15, cc = c & 31, ob = rr * 64 + cc * 2; return st * 1024 + (ob ^ (((ob >> 9) & 1) << 5)); }
__host__ __device__ __forceinline__ void stage_rc(int b, int& R, int& C) { const int st = b / 1024, sb = b % 1024, swz = sb ^ (((sb >> 9) & 1) << 5); R = (st >> 1) * 16 + swz / 64; C = (st & 1) * 32 + (swz % 64) / 2; }
__host__ __device__ __forceinline__ int perm32(int rho) { const int n = rho >> 4, i = rho & 15; return 8 * (i >> 2) + 4 * n + (i & 3); }

struct Unit { const char* a; const char* b; int pm, pn, nt, kind, aux, ui; };

DI void tile_of(int L, int nM, int nN, int& pm, int& pn) {
    const int nwg = nM * nN; int wgid = L; { const int q = nwg / 8, r = nwg % 8, xcd = wgid % 8, off = wgid / 8; wgid = (xcd < r ? xcd * (q + 1) : r * (q + 1) + (xcd - r) * q) + off; }
    const int nig = 8 * nN, gid = wgid / nig, fm = gid * 8, gsz = (nM - fm) < 8 ? (nM - fm) : 8;
    pm = fm + ((wgid % nig) % gsz); pn = (wgid % nig) / gsz;
}
struct Sched {
    const char *A, *B; int lda, ldb, nM, nN, nt, G, c;
    const char *XA, *XB; int xM0, xnM, xnN, xS, xnt;
    int pn0;
    DI bool next(int i, Unit& u) const {
        int L = i * G + c; const int nwg = nM * nN;
        if (L < nwg) { tile_of(L, nM, nN, u.pm, u.pn); u.pn += pn0; u.a = A + (size_t)u.pm * 256 * lda * 2; u.b = B + (size_t)u.pn * 256 * ldb * 2; u.nt = nt; u.kind = 0; u.aux = 0; u.ui = i; return true; }
        L -= nwg;
        if (L < xnM * xnN * xS) { const int s = L % xS, t = L / xS; const int tm = t / xnN, tn = t % xnN; u.pm = xM0 + tm; u.pn = tn; const size_t k0 = (size_t)s * xnt * 64;
            u.a = XA + ((size_t)tm * 256 * lda + k0) * 2; u.b = XB + ((size_t)tn * 256 * ldb + k0) * 2; u.nt = xnt; u.kind = 1; u.aux = s; u.ui = i; return true; }
        return false;
    }
};

template <class Epi, bool ALIGN_EPI>
DI void gemm_phase(LAS unsigned char* lds, const Sched& S, const Epi& E, int tid) {
    const int wid = __builtin_amdgcn_readfirstlane(tid >> 6), lane = tid & 63, wr = wid >> 2, wc = wid & 3, fr = lane & 15, fq = lane >> 4;
    const int lda = S.lda, ldb = S.ldb;
    unsigned voffA[2], voffB[2];
#pragma unroll
    for (int i = 0; i < 2; ++i) { int R, C; stage_rc(tid * 16 + i * 8192, R, C); const int Rb = (R & ~31) + perm32(R & 31);
        voffA[i] = (unsigned)(R * lda + C) * 2u; voffB[i] = (unsigned)(Rb * ldb + C) * 2u; }
    const size_t kstep = (size_t)(BK * 2);
    const size_t hstepA = (size_t)HALF * lda * 2, hstepB = (size_t)HALF * ldb * 2;
    const unsigned ldsw = (unsigned)wid * 1024u;
    const int aoff = lds_byte(wr * 64 + fr, fq * 8), boff = lds_byte(wc * 32 + fr, fq * 8);
#define PG8_SA(b, h) (((b) * 2 + (h)) * HTB)
#define PG8_SB(b, h) ((4 + (b) * 2 + (h)) * HTB)
#define PG8_STAGE(bufoff, gbase, voff) do { _Pragma("unroll") for (int _i = 0; _i < 2; ++_i) \
        __builtin_amdgcn_global_load_lds((const unsigned*)((const char*)(gbase) + (voff)[_i]), (LAS unsigned*)(lds + (bufoff) + ldsw + _i * 8192), 16, 0, 0); } while (0)
#define PG8_LDA(dst, b, h) do { _Pragma("unroll") for (int m = 0; m < 4; ++m) _Pragma("unroll") for (int k = 0; k < 2; ++k) dst[m][k] = *(const LAS bf16x8*)(lds + PG8_SA(b, h) + aoff + m * 2048 + k * 1024); } while (0)
#define PG8_LDB(dst, b, h) do { _Pragma("unroll") for (int n = 0; n < 2; ++n) _Pragma("unroll") for (int k = 0; k < 2; ++k) dst[n][k] = *(const LAS bf16x8*)(lds + PG8_SB(b, h) + boff + n * 2048 + k * 1024); } while (0)
#define PG8_MMA(ai, bj, At, Bt) do { __builtin_amdgcn_s_setprio(1); _Pragma("unroll") for (int m = 0; m < 4; ++m) _Pragma("unroll") for (int n = 0; n < 2; ++n) _Pragma("unroll") for (int k = 0; k < 2; ++k) \
        acc[ai][bj][m][n] = __builtin_amdgcn_mfma_f32_16x16x32_bf16(Bt[n][k], At[m][k], acc[ai][bj][m][n], 0, 0, 0); __builtin_amdgcn_s_setprio(0); } while (0)
#define PG8_WAIT_V(n) asm volatile("s_waitcnt vmcnt(" #n ")" ::: "memory")
#define PG8_WAIT_L(n) asm volatile("s_waitcnt lgkmcnt(" #n ")" ::: "memory")
#define PG8_BAR __builtin_amdgcn_s_barrier()
#define PG8_SCHED __builtin_amdgcn_sched_barrier(0)
    Unit cur, nxt; int ui = 0;
    if (!S.next(0, cur)) return;
    f32x4 acc[2][2][4][2];
#pragma unroll
    for (int a = 0; a < 2; ++a)
#pragma unroll
        for (int b = 0; b < 2; ++b)
#pragma unroll
            for (int m = 0; m < 4; ++m)
#pragma unroll
                for (int n = 0; n < 2; ++n) acc[a][b][m][n] = (f32x4){0.f, 0.f, 0.f, 0.f};
    bf16x8 At[4][2], B0[2][2], B1[2][2];
    const char* cA = cur.a; const char* cB = cur.b;
    PG8_STAGE(PG8_SB(0, 0), cB, voffB); PG8_STAGE(PG8_SB(0, 1), cB + hstepB, voffB); PG8_STAGE(PG8_SA(0, 0), cA, voffA); PG8_STAGE(PG8_SA(0, 1), cA + hstepA, voffA);
    if (wr == 1) PG8_BAR;
    PG8_WAIT_V(2); PG8_BAR;
    PG8_STAGE(PG8_SB(1, 0), cB + kstep, voffB); PG8_STAGE(PG8_SA(1, 0), cA + kstep, voffA); PG8_STAGE(PG8_SB(1, 1), cB + hstepB + kstep, voffB);
    PG8_WAIT_V(6); PG8_BAR;
    for (;;) {
        const bool has_next = S.next(ui + 1, nxt);
        const char* nA = has_next ? nxt.a : cA; const char* nB = has_next ? nxt.b : cB;
        const int nt = cur.nt;
        for (int t = 0; t < nt; t += 2) {
            const bool last = (t == nt - 2);
            const char* a1 = cA + (size_t)(t + 1) * kstep;
            const char* a2 = last ? nA : cA + (size_t)(t + 2) * kstep; const char* b2 = last ? nB : cB + (size_t)(t + 2) * kstep;
            const char* a3 = a2 + kstep; const char* b3 = b2 + kstep;
            PG8_LDB(B0, 0, 0); PG8_LDB(B1, 0, 1); PG8_SCHED; PG8_LDA(At, 0, 0); PG8_STAGE(PG8_SA(1, 1), a1 + hstepA, voffA);
            PG8_WAIT_V(8); PG8_WAIT_L(0); PG8_BAR; PG8_MMA(0, 0, At, B0); PG8_MMA(0, 1, At, B1); PG8_BAR; PG8_SCHED;
            PG8_LDA(At, 0, 1); PG8_STAGE(PG8_SB(0, 0), b2, voffB); PG8_STAGE(PG8_SB(0, 1), b2 + hstepB, voffB); PG8_STAGE(PG8_SA(0, 0), a2, voffA);
            PG8_WAIT_V(8); PG8_WAIT_L(0); PG8_BAR; PG8_MMA(1, 0, At, B0); PG8_MMA(1, 1, At, B1); PG8_BAR; PG8_SCHED;
            PG8_LDB(B0, 1, 0); PG8_LDB(B1, 1, 1); PG8_SCHED; PG8_LDA(At, 1, 0); PG8_STAGE(PG8_SA(0, 1), a2 + hstepA, voffA);
            PG8_WAIT_V(8); PG8_WAIT_L(0); PG8_BAR; PG8_MMA(0, 0, At, B0); PG8_MMA(0, 1, At, B1); PG8_BAR; PG8_SCHED;
            PG8_LDA(At, 1, 1); PG8_STAGE(PG8_SB(1, 0), b3, voffB); PG8_STAGE(PG8_SB(1, 1), b3 + hstepB, voffB); PG8_STAGE(PG8_SA(1, 0), a3, voffA);
            PG8_WAIT_V(8); PG8_WAIT_L(0); PG8_BAR; PG8_MMA(1, 0, At, B0); PG8_MMA(1, 1, At, B1); PG8_BAR; PG8_SCHED;
        }
        if constexpr (ALIGN_EPI) { if (wr == 0) PG8_BAR; }
        E(acc, cur, wr, wc, fr, fq);
        if (!has_next) break;
#pragma unroll
        for (int a = 0; a < 2; ++a)
#pragma unroll
            for (int b = 0; b < 2; ++b)
#pragma unroll
                for (int m = 0; m < 4; ++m)
#pragma unroll
                    for (int n = 0; n < 2; ++n) acc[a][b][m][n] = (f32x4){0.f, 0.f, 0.f, 0.f};
        cur = nxt; cA = nA; cB = nB; ++ui;
        if constexpr (ALIGN_EPI) { if (wr == 1) PG8_BAR; }
    }
    PG8_WAIT_V(0);
    if constexpr (!ALIGN_EPI) { if (wr == 0) PG8_BAR; }
    PG8_BAR;
#undef PG8_SA
#undef PG8_SB
#undef PG8_STAGE
#undef PG8_LDA
#undef PG8_LDB
#undef PG8_MMA
#undef PG8_WAIT_V
#undef PG8_WAIT_L
#undef PG8_BAR
#undef PG8_SCHED
}
typedef f32x4 Acc[2][2][4][2];
}
struct Args { const float* in[N_IN]; float* out; unsigned char* ws; int ph_lo, ph_hi; };
struct Frame {
    LAS unsigned char* lds;
    volatile LAS unsigned* MISC;
    gu32* ctl;
    int tid, lane, wave, G, bid;
};

DI u32x4 pack8(f32x4 a, f32x4 b) { u32x4 w; w.x = pk2(a[0], a[1]); w.y = pk2(a[2], a[3]); w.z = pk2(b[0], b[1]); w.w = pk2(b[2], b[3]); return w; }

struct EpiSwiGLU {
    bf16* ACT; const LAS float* rs;
    DI void operator()(const pg8::Acc& acc, const pg8::Unit& u, int wr, int wc, int fr, int fq) const {
        const int row0 = u.pm * 256 + wr * 64 + fr, col = u.pn * 128 + wc * 32 + 8 * fq;
        const LAS float* rt = rs + u.ui * 256 + wr * 64 + fr;
#pragma unroll
        for (int ai = 0; ai < 2; ++ai)
#pragma unroll
            for (int m = 0; m < 4; ++m) {
                const float r = rt[ai * 128 + m * 16], rl = -LOG2E * r, r2 = r * r;
                const f32x4 g0 = acc[ai][0][m][0], g1 = acc[ai][0][m][1];
                f32x4 e0 = g0 * rl, e1 = g1 * rl;
#pragma unroll
                for (int e = 0; e < 4; ++e) { e0[e] = fast_exp2(e0[e]); e1[e] = fast_exp2(e1[e]); }
                e0 = e0 + 1.f; e1 = e1 + 1.f;
#pragma unroll
                for (int e = 0; e < 4; ++e) { e0[e] = fast_rcp(e0[e]); e1[e] = fast_rcp(e1[e]); }
                const f32x4 r0 = (g0 * acc[ai][1][m][0]) * (e0 * r2), r1 = (g1 * acc[ai][1][m][1]) * (e1 * r2);
                *(u32x4*)(ACT + (size_t)(row0 + ai * 128 + m * 16) * ALD + col) = pack8(r0, r1);
            }
    }
};
struct EpiResid {
    unsigned char* ws; float scale; int site;
    DI void operator()(const pg8::Acc& acc, const pg8::Unit& u, int wr, int wc, int fr, int fq) const {
        const int row0 = u.pm * 256 + wr * 64 + fr, col0 = u.pn * 256 + wc * 32 + 8 * fq;
        if (u.kind == 0) {
            float* X = (float*)(ws + WS_X); float* SSP = (float*)(ws + WS_SSP) + (size_t)site * MT * 16;
#pragma unroll
            for (int ai = 0; ai < 2; ++ai) {
                bf16* XH = (bf16*)X;
                u32x4 xv[4][2];
#pragma unroll
                for (int m = 0; m < 4; ++m)
#pragma unroll
                    for (int bj = 0; bj < 2; ++bj) xv[m][bj] = *(const u32x4*)(XH + (size_t)(row0 + ai * 128 + m * 16) * DM + col0 + bj * 128);
#pragma unroll
                for (int m = 0; m < 4; ++m) { const int row = row0 + ai * 128 + m * 16; float ssq = 0.f;
#pragma unroll
                    for (int bj = 0; bj < 2; ++bj) { const u32x4 x = xv[m][bj];
                        const f32x4 xa = (f32x4){bflo(x.x), bfhi(x.x), bflo(x.y), bfhi(x.y)} + acc[ai][bj][m][0] * scale, xb = (f32x4){bflo(x.z), bfhi(x.z), bflo(x.w), bfhi(x.w)} + acc[ai][bj][m][1] * scale;
                        *(u32x4*)(XH + (size_t)row * DM + col0 + bj * 128) = pack8(xa, xb);
                        ssq += ((xa[0] * xa[0] + xa[1] * xa[1]) + (xa[2] * xa[2] + xa[3] * xa[3])) + ((xb[0] * xb[0] + xb[1] * xb[1]) + (xb[2] * xb[2] + xb[3] * xb[3])); }
                    ssq += __shfl_xor(ssq, 16); ssq += __shfl_xor(ssq, 32);
                    if (fq == 0) SSP[(size_t)row * 16 + u.pn * 4 + wc] = ssq; }
            }
        } else {
            bf16* sb = (bf16*)(ws + WS_SLAB) + (size_t)u.aux * NS * DM;
#pragma unroll
            for (int ai = 0; ai < 2; ++ai)
#pragma unroll
                for (int m = 0; m < 4; ++m) { bf16* rp = sb + (size_t)(row0 - NP + ai * 128 + m * 16) * DM + col0;
#pragma unroll
                    for (int bj = 0; bj < 2; ++bj) *(u32x4*)(rp + bj * 128) = pack8(acc[ai][bj][m][0], acc[ai][bj][m][1]); }
        }
    }
};
constexpr float QSCALE = 0.17677669529663687f * LOG2E;
struct EpiWin {
    bf16* P; float *okp, *ovp, *oks, *ovs; float *omk, *omv; bf16 *MK, *MV; const LAS float* rs;
    DI void operator()(const pg8::Acc& acc, const pg8::Unit& u, int wr, int wc, int fr, int fq) const {
        const int row0 = u.pm * 256 + wr * 64 + fr, cl = wc * 32 + 8 * fq;
        if (u.kind == 0) {
            const int pn = u.pn;
#pragma unroll
            for (int ai = 0; ai < 2; ++ai)
#pragma unroll
                for (int m = 0; m < 4; ++m) { const int row = row0 + ai * 128 + m * 16; const float r = rs[u.ui * 256 + wr * 64 + fr + ai * 128 + m * 16] * (pn == 1 ? QSCALE : 1.f);
#pragma unroll
                    for (int bj = 0; bj < 2; ++bj) { f32x4 a = acc[ai][bj][m][0] * r, b = acc[ai][bj][m][1] * r;
                        if (pn >= 6) {
#pragma unroll
                            for (int e = 0; e < 4; ++e) { a[e] = gelu_tanh(a[e]); b[e] = gelu_tanh(b[e]); } }
                        if (pn == 2 || pn == 3) { float* o = (pn == 2) ? (row < NP ? okp + (size_t)row * 256 : oks + (size_t)(row - NP) * 256) : (row < NP ? ovp + (size_t)row * 256 : ovs + (size_t)(row - NP) * 256);
                            f32x4* q = (f32x4*)(o + cl + bj * 128); q[0] = a; q[1] = b; }
                        *(u32x4*)(P + (size_t)row * INW + pn * 256 + cl + bj * 128) = pack8(a, b); } }
        } else {
            const bool isv = u.pn >= 2; float* o = isv ? omv : omk; bf16* ob = isv ? MV : MK; const int cb = (u.pn & 1) * 256 + cl;
#pragma unroll
            for (int ai = 0; ai < 2; ++ai)
#pragma unroll
                for (int m = 0; m < 4; ++m) { const int row = row0 + ai * 128 + m * 16;
#pragma unroll
                    for (int bj = 0; bj < 2; ++bj) { const f32x4 a = acc[ai][bj][m][0], b = acc[ai][bj][m][1];
                        f32x4* q = (f32x4*)(o + (size_t)row * XW + cb + bj * 128); q[0] = a; q[1] = b;
                        *(u32x4*)(ob + (size_t)row * XW + cb + bj * 128) = pack8(a, b); } }
        }
    }
};
constexpr float XQSCALE = 0.08838834764831845f * LOG2E;
struct EpiQ {
    bf16* Q; const LAS float* rs;
    DI void operator()(const pg8::Acc& acc, const pg8::Unit& u, int wr, int wc, int fr, int fq) const {
        const int row0 = u.pm * 256 + wr * 64 + fr, col0 = u.pn * 256 + wc * 32 + 8 * fq;
#pragma unroll
        for (int ai = 0; ai < 2; ++ai)
#pragma unroll
            for (int m = 0; m < 4; ++m) { const float r = rs[u.ui * 256 + wr * 64 + fr + ai * 128 + m * 16] * XQSCALE;
#pragma unroll
                for (int bj = 0; bj < 2; ++bj)
                    *(u32x4*)(Q + (size_t)(row0 + ai * 128 + m * 16) * XW + col0 + bj * 128) = pack8(acc[ai][bj][m][0] * r, acc[ai][bj][m][1] * r); }
    }
};

struct CvtDesc { const float* src; const float* gain; bf16* dst; int N, ldt, k0; };
DI void cvt_load(const CvtDesc& d, int lane, f32x2 (&wv)[32]) {
#pragma unroll
    for (int i = 0; i < 32; ++i) wv[i] = __builtin_nontemporal_load((const f32x2*)(d.src + (size_t)i * d.N + 2 * lane));
}
DI void cvt_store(const CvtDesc& d, int lane, f32x2 (&wv)[32], LAS float* scr) {
    if (d.gain) {
#pragma unroll
        for (int i = 0; i < 32; ++i) wv[i] = wv[i] * d.gain[d.k0 + i]; }
#pragma unroll
    for (int i = 0; i < 32; ++i) *(LAS f32x2*)(scr + i * 130 + 2 * lane) = wv[i];
    LDS_WAIT(); asm volatile("" ::: "memory");
    const int c = lane & 3;
#pragma unroll
    for (int j = 0; j < 8; ++j) { const int n = (lane >> 2) + 16 * j; const LAS float* s = scr + (8 * c) * 130 + n;
        u32x4 o; o.x = pk2(s[0 * 130], s[1 * 130]); o.y = pk2(s[2 * 130], s[3 * 130]); o.z = pk2(s[4 * 130], s[5 * 130]); o.w = pk2(s[6 * 130], s[7 * 130]);
        *(GAS u32x4*)(d.dst + (size_t)n * d.ldt + 8 * c) = o; }
    LDS_WAIT(); asm volatile("" ::: "memory");
}
DI CvtDesc cvt_mk(const float* W, int K, int N, const float* gain, bf16* WT, int row_off, int map, int item, int ldt) {
    const int nnb = N / 128, nb = item % nnb, kb = item / nnb, n0 = 128 * nb, k0 = 32 * kb;
    int drow0 = row_off + n0;
    if (map) drow0 = row_off + 256 * (n0 >> 7) + (map == 2 ? 128 : 0);
    const int ld = ldt ? ldt : K;
    CvtDesc d; d.src = W + (size_t)k0 * N + n0; d.gain = gain; d.dst = WT + (size_t)drow0 * ld + k0; d.N = N; d.ldt = ld; d.k0 = k0; return d;
}
struct BigDesc { const float* src; const float* gain; bf16* dst; int N, ldt, map; };
constexpr int BT_FF = (DM / 64) * (DFF / 512), BT_DN = (DFF / 64) * (DM / 512), BT_IN = (DM / 64) * (INW / 512), BT_OUT = (DM / 64) * (DM / 512), BT_Q = (DM / 64) * (XW / 512), BT_O = (XW / 64) * (DM / 512);
constexpr int BT_LAYER = 4 * BT_FF + 2 * BT_DN + BT_IN + BT_OUT + 3 * BT_Q + BT_O, BT_EARLY = 2 * BT_FF + BT_DN + BT_IN + 2 * BT_Q;
DI BigDesc big_mk(const float* W, int K, int N, const float* gain, bf16* WT, int row_off, int map, int item, int ldt, int& n0) {
    const int nnb = N / 512, nb = item % nnb, kb = item / nnb, k0 = 64 * kb; n0 = 512 * nb;
    const int ld = ldt ? ldt : K;
    BigDesc d; d.src = W + (size_t)k0 * N + n0; d.gain = gain ? gain + k0 : nullptr; d.dst = WT + (size_t)row_off * ld + k0; d.N = N; d.ldt = ld; d.map = map; return d;
}
DI BigDesc big_desc(const Args& a, int it, int& n0) {
    const int l = it / BT_LAYER; int r = it % BT_LAYER;
    unsigned char* ws = a.ws; unsigned char* wl = ws + WS_W + (size_t)l * LW;
    const size_t oFF = (size_t)l * DM * DFF, oIN = (size_t)l * DM * INW, oDD = (size_t)l * DM * DM, oXQ = (size_t)l * DM * XW;
    if (r < BT_FF) return big_mk(a.in[I_F1G] + oFF, DM, DFF, a.in[I_F1N] + l * DM, (bf16*)(wl + W_GU1), 0, 1, r, 0, n0); r -= BT_FF;
    if (r < BT_FF) return big_mk(a.in[I_F1U] + oFF, DM, DFF, a.in[I_F1N] + l * DM, (bf16*)(wl + W_GU1), 0, 2, r, 0, n0); r -= BT_FF;
    if (r < BT_DN) return big_mk(a.in[I_F1D] + oFF, DFF, DM, nullptr, (bf16*)(wl + W_D1), 0, 0, r, ALD, n0); r -= BT_DN;
    if (r < BT_IN) return big_mk(a.in[I_WIN] + oIN, DM, INW, a.in[I_MIXN] + l * DM, (bf16*)(wl + W_IN), 0, 0, r, 0, n0); r -= BT_IN;
    if (r < BT_Q) return big_mk(a.in[I_XWK] + oXQ, DM, XW, a.in[I_MEMNORM] + l * DM, (bf16*)(ws + WS_WKV), l * 1024, 0, r, 0, n0); r -= BT_Q;
    if (r < BT_Q) return big_mk(a.in[I_XWV] + oXQ, DM, XW, a.in[I_MEMNORM] + l * DM, (bf16*)(ws + WS_WKV), l * 1024 + 512, 0, r, 0, n0); r -= BT_Q;
    if (r < BT_FF) return big_mk(a.in[I_F2G] + oFF, DM, DFF, a.in[I_F2N] + l * DM, (bf16*)(wl + W_GU2), 0, 1, r, 0, n0); r -= BT_FF;
    if (r < BT_FF) return big_mk(a.in[I_F2U] + oFF, DM, DFF, a.in[I_F2N] + l * DM, (bf16*)(wl + W_GU2), 0, 2, r, 0, n0); r -= BT_FF;
    if (r < BT_DN) return big_mk(a.in[I_F2D] + oFF, DFF, DM, nullptr, (bf16*)(wl + W_D2), 0, 0, r, ALD, n0); r -= BT_DN;
    if (r < BT_OUT) return big_mk(a.in[I_WOUT] + oDD, DM, DM, nullptr, (bf16*)(wl + W_OUT), 0, 0, r, 0, n0); r -= BT_OUT;
    if (r < BT_Q) return big_mk(a.in[I_XWQ] + oXQ, DM, XW, a.in[I_XN] + l * DM, (bf16*)(wl + W_Q), 0, 0, r, 0, n0); r -= BT_Q;
    return big_mk(a.in[I_XWO] + oXQ, XW, DM, nullptr, (bf16*)(wl + W_O), 0, 0, r, 0, n0);
}
DI void big_load(const BigDesc& d, int tid, f32x4 (&w)[16]) {
#pragma unroll
    for (int i = 0; i < 16; ++i) { const int idx = tid + i * NTHR, row = idx >> 7, c4 = idx & 127; w[i] = __builtin_nontemporal_load((const f32x4*)(d.src + (size_t)row * d.N + 4 * c4)); }
}
DI void big_to_lds(const BigDesc& d, int tid, const f32x4 (&w)[16], LAS float* T) {
#pragma unroll
    for (int i = 0; i < 16; ++i) { const int idx = tid + i * NTHR, row = idx >> 7, c4 = idx & 127; const float g = d.gain ? d.gain[row] : 1.f;
        LAS float* p = T + row * 513 + 4 * c4; p[0] = w[i][0] * g; p[1] = w[i][1] * g; p[2] = w[i][2] * g; p[3] = w[i][3] * g; }
}
DI void big_store(const BigDesc& d, int n0, int tid, const LAS float* T) {
#pragma unroll
    for (int j = 0; j < 8; ++j) { const int cidx = tid + j * NTHR, n = cidx >> 3, c = cidx & 7; const LAS float* s = T + (8 * c) * 513 + n;
        u32x4 o; o.x = pk2(s[0 * 513], s[1 * 513]); o.y = pk2(s[2 * 513], s[3 * 513]); o.z = pk2(s[4 * 513], s[5 * 513]); o.w = pk2(s[6 * 513], s[7 * 513]);
        const int ng = n0 + n; const int drow = d.map ? 256 * (ng >> 7) + (ng & 127) + (d.map == 2 ? 128 : 0) : ng;
        *(GAS u32x4*)(d.dst + (size_t)drow * d.ldt + 8 * c) = o; }
}
DI void prologue_weights_big(const Args& a, const Frame& F) {
    LAS float* T = (LAS float*)F.lds;
    constexpr int NIT = BT_EARLY;
    int it = F.bid; if (it >= NIT) return;
    int n0 = 0, n1 = 0;
    f32x4 w[16];
    BigDesc d = big_desc(a, it, n0); big_load(d, F.tid, w);
    for (;;) {
        big_to_lds(d, F.tid, w, T);
        __syncthreads();
        const bool more = it + F.G < NIT; BigDesc dn = d;
        if (more) { dn = big_desc(a, it + F.G, n1); big_load(dn, F.tid, w); }
        big_store(d, n0, F.tid, T);
        __syncthreads();
        if (!more) break;
        d = dn; n0 = n1; it += F.G;
    }
}
constexpr int IT_S = (256 / 32) * (256 / 128);
constexpr int IT_LAYER = 2 * IT_S;
DI CvtDesc cvt_desc(const Args& a, int it) {
    const int l = it / IT_LAYER; int r = it % IT_LAYER;
    unsigned char* wl = a.ws + WS_W + (size_t)l * LW; const size_t oSS = (size_t)l * 65536;
    if (r < IT_S) return cvt_mk(a.in[I_WGLU] + oSS, 256, 256, nullptr, (bf16*)(wl + W_SMALL + S_WGLU), 0, 0, r, 0); r -= IT_S;
    return cvt_mk(a.in[I_CPW] + oSS, 256, 256, nullptr, (bf16*)(wl + W_SMALL + S_WPW), 0, 0, r, 0);
}
DI void prologue_weights(const Args& a, const Frame& F, int pmode = 0) {
    (void)pmode;
    prologue_weights_big(a, F);
    __syncthreads();
    LAS float* scr = (LAS float*)(F.lds + F.wave * 16768);
    const int gw = F.bid * NWAVES + F.wave, NGW = F.G * NWAVES, NIT = DEPTH * IT_LAYER;
    f32x2 wa[32];
    for (int it = gw; it < NIT; it += NGW) { const CvtDesc da = cvt_desc(a, it); cvt_load(da, F.lane, wa); cvt_store(da, F.lane, wa, scr); }
}

DI void prologue_tables(const Args& a, const Frame& F) {
    const int gt = F.bid * NTHR + F.tid, NGT = F.G * NTHR;
    unsigned char* ws = a.ws;
    for (int e = gt; e < DEPTH * 4 * 128 * 128; e += NGT) { const int l = e >> 16, r = e & 65535, i = (r >> 7) & 127, j = r & 127;
        const float v = (j <= i) ? a.in[I_GWS][e] : 0.f; ((bf16*)(ws + WS_W + (size_t)l * LW + W_SMALL + S_GMLPW))[r] = (bf16)f2bf(v); }
    for (int e16 = gt; e16 < DEPTH * 16 * 64 * 16; e16 += NGT) { const int e = e16 >> 4, c = e16 & 15, l = e >> 10, gp = e & 1023, g = gp >> 6, p = gp & 63;
        unsigned char* sm = ws + WS_W + (size_t)l * LW + W_SMALL;
        const float ar = a.in[I_AR][e], ai = a.in[I_AI][e], dt = expf(a.in[I_LDT][l * 16 + g]);
        const float br = a.in[I_BR][(size_t)e * 16 + c], bi = a.in[I_BI][(size_t)e * 16 + c];
        const size_t ce = ((size_t)(l * 16 + g) * 16 + c) * 64 + p;
        const float ccr = a.in[I_CR][ce], cci = a.in[I_CI][ce];
        float pw_re[3], pw_im[3];
#pragma unroll
        for (int q = 0; q < 3; ++q) { const float kk = (q == 0) ? 1.f : (q == 1 ? 64.f : 128.f);
            const double ang = (double)ai * (double)dt * (double)kk; const double nrot = rint(ang * 0.15915494309189535); const float rr = (float)(ang - nrot * 6.283185307179586);
            const float mag = expf(ar * dt * kk); pw_re[q] = mag * cosf(rr); pw_im[q] = mag * sinf(rr); }
        if (c == 0) {
            ((float*)(sm + S_AB))[gp * 2] = pw_re[0]; ((float*)(sm + S_AB))[gp * 2 + 1] = pw_im[0];
            ((float*)(sm + S_A64))[gp * 2] = pw_re[1]; ((float*)(sm + S_A64))[gp * 2 + 1] = pw_im[1];
            ((float*)(sm + S_A256))[gp * 2] = pw_re[2]; ((float*)(sm + S_A256))[gp * 2 + 1] = pw_im[2]; }
        const float nr = pw_re[0] - 1.f, ni = pw_im[0], den = ar * ar + ai * ai;
        const float cr = (nr * ar + ni * ai) / den, ci = (ni * ar - nr * ai) / den;
        bf16* bb = (bf16*)(sm + S_BBART); bf16* cm = (bf16*)(sm + S_CMT);
        bb[(g * 128 + p) * 16 + c] = (bf16)f2bf(cr * br - ci * bi); bb[(g * 128 + 64 + p) * 16 + c] = (bf16)f2bf(cr * bi + ci * br);
        cm[(g * 16 + c) * 128 + p] = (bf16)f2bf(ccr); cm[(g * 16 + c) * 128 + 64 + p] = (bf16)f2bf(-cci);
    }
    if (gt < DEPTH) { const int l = gt; float d1 = 0.f, d2 = 0.f;
        for (int i = 0; i < 32; ++i) { d1 += a.in[I_LQ1][l * 32 + i] * a.in[I_LK1][l * 32 + i]; d2 += a.in[I_LQ2][l * 32 + i] * a.in[I_LK2][l * 32 + i]; }
        const float lam_init = 0.8f - 0.6f * expf(-0.3f * (float)l);
        float* lp = (float*)(ws + WS_W + (size_t)l * LW + W_SMALL + S_LAM); lp[0] = expf(d1) - expf(d2) + lam_init; lp[1] = lam_init; }
}

template <int MODE>
DI void norm_phase(const Args& a, const Frame& F, int nslab, float sscale, float* RSTD, const float* SSP) {
    constexpr int RB = 3;
    const int gw = F.bid * NWAVES + F.wave, NGW = F.G * NWAVES;
    bf16* X = (bf16*)(a.ws + WS_X); const float* SL = (const float*)(a.ws + WS_SLAB);
    if (MODE == 0) {
        for (int row = F.bid * NTHR + F.tid; row < NP; row += F.G * NTHR) { const f32x4* q = (const f32x4*)(SSP + (size_t)row * 16); const f32x4 p = (q[0] + q[1]) + (q[2] + q[3]);
            RSTD[row] = 1.f / sqrtf(((p[0] + p[1]) + (p[2] + p[3])) * (1.f / DM) + EPS); }
    }
    const int r_lo = (MODE == 0) ? NP : 0;
    for (int rowb = r_lo + gw; rowb < MT; rowb += RB * NGW) {
        f32x4 v[RB][4]; int rows[RB]; bool ok[RB];
#pragma unroll
        for (int r = 0; r < RB; ++r) { const int row = rowb + r * NGW; ok[r] = row < MT; rows[r] = ok[r] ? row : rowb;
            if (MODE == 1) { const float* src = rows[r] < NP ? a.in[I_XP] + (size_t)rows[r] * DM : a.in[I_XS] + (size_t)(rows[r] - NP) * DM;
#pragma unroll
                for (int j = 0; j < 4; ++j) v[r][j] = ((const f32x4*)src)[F.lane + 64 * j]; }
            else { const u32x2* src = (const u32x2*)(X + (size_t)rows[r] * DM);
#pragma unroll
                for (int j = 0; j < 4; ++j) { const u32x2 w = src[F.lane + 64 * j]; v[r][j] = (f32x4){bflo(w.x), bfhi(w.x), bflo(w.y), bfhi(w.y)}; } } }
        if (MODE != 1 && nslab > 0) {
#pragma unroll
            for (int r = 0; r < RB; ++r) if (rows[r] >= NP) {
#pragma unroll
                for (int hb = 0; hb < 2; ++hb) {
                    u32x2 t[4][4];
#pragma unroll
                    for (int s4 = 0; s4 < 4; ++s4) { const int s = hb * 4 + s4; const u32x2* sp = (const u32x2*)((const bf16*)SL + ((size_t)(s < nslab ? s : 0) * NS + (rows[r] - NP)) * DM);
#pragma unroll
                        for (int j = 0; j < 4; ++j) t[s4][j] = sp[F.lane + 64 * j]; }
#pragma unroll
                    for (int s4 = 0; s4 < 4; ++s4) { const float wsc = (hb * 4 + s4 < nslab) ? sscale : 0.f;
#pragma unroll
                        for (int j = 0; j < 4; ++j) v[r][j] = v[r][j] + (f32x4){bflo(t[s4][j].x), bfhi(t[s4][j].x), bflo(t[s4][j].y), bfhi(t[s4][j].y)} * wsc; }
                }
            }
        }
        float ss[RB];
#pragma unroll
        for (int r = 0; r < RB; ++r) { ss[r] = 0.f;
#pragma unroll
            for (int j = 0; j < 4; ++j) ss[r] += (v[r][j][0] * v[r][j][0] + v[r][j][1] * v[r][j][1]) + (v[r][j][2] * v[r][j][2] + v[r][j][3] * v[r][j][3]); }
        wave_sum_n<RB>(ss);
#pragma unroll
        for (int r = 0; r < RB; ++r) if (ok[r]) { const int row = rows[r];
            const float rstd = 1.f / sqrtf(ss[r] * (1.f / DM) + EPS);
            if (MODE == 2) {
                float* o = (row < NP) ? a.out + O_YP + (size_t)row * DM : a.out + O_YS + (size_t)(row - NP) * DM;
#pragma unroll
                for (int j = 0; j < 4; ++j) { const f32x4 g = ((const f32x4*)a.in[I_FINAL])[F.lane + 64 * j]; ((f32x4*)o)[F.lane + 64 * j] = v[r][j] * rstd * g; }
            } else {
                if (F.lane == 0) RSTD[row] = rstd;
#pragma unroll
                for (int j = 0; j < 4; ++j) { u32x2 w; w.x = pk2(v[r][j][0], v[r][j][1]); w.y = pk2(v[r][j][2], v[r][j][3]); ((u32x2*)(X + (size_t)row * DM))[F.lane + 64 * j] = w; }
            }
        }
    }
}
DI void fill_rs_table(const Frame& F, const pg8::Sched& S, const float* RSTD) {
    LAS float* rs = (LAS float*)(F.lds + LDS_RS);
    for (int i = 0; i < 9; ++i) { pg8::Unit u; if (!S.next(i, u)) break;
        if (u.kind == 0 && F.tid < 256) rs[i * 256 + F.tid] = RSTD[u.pm * 256 + F.tid]; }
    __syncthreads();
}
DI void memnorm_phase(const Args& a, const Frame& F) {
    const int gw = F.bid * NWAVES + F.wave, NGW = F.G * NWAVES;
    bf16* MN = (bf16*)(a.ws + WS_MEMN);
    for (int row = gw; row < BP * NMEM; row += NGW) {
        const f32x4* src = (const f32x4*)(a.in[I_MEM] + (size_t)row * DM);
        f32x4 v[4]; float ss = 0.f;
#pragma unroll
        for (int j = 0; j < 4; ++j) { v[j] = src[F.lane + 64 * j]; ss += (v[j][0] * v[j][0] + v[j][1] * v[j][1]) + (v[j][2] * v[j][2] + v[j][3] * v[j][3]); }
        const float rstd = 1.f / sqrtf(wave_sum(ss) * (1.f / DM) + EPS);
        u32x2* o8 = (u32x2*)(MN + (size_t)row * DM);
#pragma unroll
        for (int j = 0; j < 4; ++j) { u32x2 w; w.x = pk2(v[j][0] * rstd, v[j][1] * rstd); w.y = pk2(v[j][2] * rstd, v[j][3] * rstd); o8[F.lane + 64 * j] = w; }
    }
}
#define MFMA16(a, b, c) __builtin_amdgcn_mfma_f32_16x16x32_bf16((a), (b), (c), 0, 0, 0)
constexpr int CNT_CONV = 0, CNT_GMLP = 1, CNT_ATTN = 2, CNT_SSM2 = 3, CNT_XATTN = 4, CNT_SSM1DONE = 10, CNT_CVT = 11;
DI gu32* cnt_word(const Frame& F, int l, int k) { return F.ctl + CW_CNT + 64 * (l * 16 + k); }
DI int next_unit(const Frame& F, gu32* ctr) {
    __syncthreads();
    if (F.tid == 0) F.MISC[4] = __hip_atomic_fetch_add(ctr, 1u, RLX_AGENT);
    __syncthreads();
    return __builtin_amdgcn_readfirstlane((int)F.MISC[4]);
}
DI unsigned deal_prefetch(const Frame& F, gu32* ctr) { unsigned t = 0u; if (F.tid == 0) t = __hip_atomic_fetch_add(ctr, 1u, RLX_AGENT); return t; }
DI int deal_publish(const Frame& F, unsigned t) {
    __syncthreads();
    if (F.tid == 0) F.MISC[4] = t;
    __syncthreads();
    return __builtin_amdgcn_readfirstlane((int)F.MISC[4]);
}
#define DEAL_LOOP(F, ctr, N, BODY) do { gu32* _c = (ctr); int u = F.bid; while (u < (N)) { const unsigned _t = deal_prefetch(F, _c); BODY; u = deal_publish(F, _t) + F.G; } __syncthreads(); } while (0)
#define DEAL_LOOP_DYN(F, ctr, N, BODY) do { gu32* _c = (ctr); int u = next_unit(F, _c); while (u < (N)) { const unsigned _t = deal_prefetch(F, _c); BODY; u = deal_publish(F, _t); } __syncthreads(); } while (0)
DI void signal_done(const Frame& F, gu32* ctr) { asm volatile("s_waitcnt vmcnt(0)" ::: "memory"); __syncthreads(); if (F.tid == 0) (void)__hip_atomic_fetch_add(ctr, 1u, RLX_AGENT); }
DI void signal_done_release(const Frame& F, gu32* ctr) {
    asm volatile("s_waitcnt vmcnt(0)" ::: "memory"); __syncthreads();
    if (F.tid == 0) { __builtin_amdgcn_fence(__ATOMIC_RELEASE, "agent"); asm volatile("s_waitcnt vmcnt(0)" ::: "memory"); (void)__hip_atomic_fetch_add(ctr, 1u, RLX_AGENT); }
}
DI void wait_done(const Frame& F, gu32* ctr, unsigned need) {
    if (F.tid == 0) { unsigned sp = 0; while (__hip_atomic_load(ctr, RLX_AGENT) < need) { __builtin_amdgcn_s_sleep(2); if (++sp > (1u << 22)) break; }
        __builtin_amdgcn_fence(__ATOMIC_ACQUIRE, "agent"); asm volatile("s_waitcnt vmcnt(0)" ::: "memory"); }
    __syncthreads();
}
DI bf16x8 zero8() { return (bf16x8){0, 0, 0, 0, 0, 0, 0, 0}; }
DI bf16x8 ld8g(const bf16* p) { return __builtin_bit_cast(bf16x8, *(const u32x4*)p); }
DI bf16x8 ld8l(const LAS unsigned char* p) { return *(const LAS bf16x8*)p; }
DI bf16x8 cat44(u32x2 lo, u32x2 hi) { u32x4 w; w.x = lo.x; w.y = lo.y; w.z = hi.x; w.w = hi.y; return __builtin_bit_cast(bf16x8, w); }
DI float max3f(float a, float b, float c) { float r; asm("v_max3_f32 %0, %1, %2, %3" : "=v"(r) : "v"(a), "v"(b), "v"(c)); return r; }
DI void lds_barrier() { asm volatile("s_waitcnt lgkmcnt(0)" ::: "memory"); __builtin_amdgcn_s_barrier(); asm volatile("" ::: "memory"); }
constexpr int CV_PER = 2;
static_assert(BT_LAYER % CV_PER == 0 && BT_EARLY % CV_PER == 0, "conversion units");
DI void cvt_unit(const Args& a, const Frame& F, int it0) {
    LAS float* T = (LAS float*)F.lds;
    int n0 = 0, n1 = 0; f32x4 w[16];
    BigDesc d = big_desc(a, it0, n0); big_load(d, F.tid, w);
#pragma unroll 1
    for (int i = 0; i < CV_PER; ++i) {
        big_to_lds(d, F.tid, w, T);
        lds_barrier();
        BigDesc dn = d;
        if (i + 1 < CV_PER) { dn = big_desc(a, it0 + i + 1, n1); big_load(dn, F.tid, w); }
        big_store(d, n0, F.tid, T);
        lds_barrier();
        d = dn; n0 = n1;
    }
}
typedef short v4i16_t __attribute__((ext_vector_type(4)));
DI u32x2 tr4(const LAS unsigned char* p) { return __builtin_bit_cast(u32x2, __builtin_amdgcn_ds_read_tr16_b64_v4i16((LAS v4i16_t*)p)); }
DI bf16x8 packp(f32x4 a, f32x4 b) { return __builtin_bit_cast(bf16x8, pack8(a, b)); }

DI void mm64_loadb(const bf16* WT, int wave, int lane, bf16x8 (&bfr)[2][8]) {
    const int fr = lane & 15, fq = lane >> 4;
#pragma unroll
    for (int ct = 0; ct < 2; ++ct)
#pragma unroll
        for (int ks = 0; ks < 8; ++ks) bfr[ct][ks] = ld8g(WT + (size_t)(32 * wave + 16 * ct + fr) * 256 + 32 * ks + 8 * fq);
}
DI void mm64_compute(const LAS unsigned char* A, int lda_b, const bf16x8 (&bfr)[2][8], int lane, f32x4 (&acc)[4][2]) {
    const int fr = lane & 15, fq = lane >> 4;
#pragma unroll
    for (int rt = 0; rt < 4; ++rt) { acc[rt][0] = (f32x4){0.f, 0.f, 0.f, 0.f}; acc[rt][1] = (f32x4){0.f, 0.f, 0.f, 0.f}; }
#pragma unroll
    for (int rt = 0; rt < 4; ++rt)
    {
        bf16x8 af[8];
#pragma unroll
        for (int ks = 0; ks < 8; ++ks) af[ks] = ld8l(A + (16 * rt + fr) * lda_b + (32 * ks + 8 * fq) * 2);
#pragma unroll
        for (int ks = 0; ks < 8; ++ks) { acc[rt][0] = MFMA16(af[ks], bfr[0][ks], acc[rt][0]); acc[rt][1] = MFMA16(af[ks], bfr[1][ks], acc[rt][1]); }
        __builtin_amdgcn_sched_barrier(0);
    }
}
DI void mm64(const LAS unsigned char* A, int lda_b, const bf16* WT, int wave, int lane, f32x4 (&acc)[4][2]) {
    bf16x8 bfr[2][8]; mm64_loadb(WT, wave, lane, bfr); mm64_compute(A, lda_b, bfr, lane, acc);
}

constexpr int SSM_WREG = 12800, SSM_BU = 0, SSM_S = 8448, SSM_G = 8 * SSM_WREG;
template <bool WRITE_S>
DI void ssm_block16(LAS unsigned char* wl, const bf16x8 uf, const bf16x8 (&bb)[8], float ar, float ai, float& sr, float& si, int lane) {
    const int fr = lane & 15, fq = lane >> 4;
    LAS float* BU = (LAS float*)(wl + SSM_BU);
#pragma unroll
    for (int nt = 0; nt < 8; ++nt) { const f32x4 c = MFMA16(uf, bb[nt], ((f32x4){0.f, 0.f, 0.f, 0.f}));
#pragma unroll
        for (int j = 0; j < 4; ++j) BU[(4 * fq + j) * 132 + 16 * nt + fr] = c[j]; }
    LDS_WAIT(); asm volatile("" ::: "memory");
    float bre[16], bim[16];
#pragma unroll
    for (int t = 0; t < 16; ++t) { bre[t] = BU[t * 132 + lane]; bim[t] = BU[t * 132 + 64 + lane]; }
    LAS bf16* S = (LAS bf16*)(wl + SSM_S);
#pragma unroll
    for (int t = 0; t < 16; ++t) { const float nr = ar * sr - ai * si + bre[t], ni = ar * si + ai * sr + bim[t]; sr = nr; si = ni;
        if (WRITE_S) { S[t * 136 + lane] = (bf16)f2bf(sr); S[t * 136 + 64 + lane] = (bf16)f2bf(si); } }
    LDS_WAIT(); asm volatile("" ::: "memory");
}
DI void ssm_load_bb(const bf16* BBT, int g, int lane, bf16x8 (&bb)[8]) {
    const int fr = lane & 15, fq = lane >> 4;
#pragma unroll
    for (int nt = 0; nt < 8; ++nt) bb[nt] = (fq < 2) ? ld8g(BBT + (size_t)(g * 128 + 16 * nt + fr) * 16 + 8 * fq) : zero8();
}
DI void ssm_pass1(const Args& a, const Frame& F, int l) {
    const unsigned char* sm = a.ws + WS_W + (size_t)l * LW + W_SMALL;
    const bf16* P = (const bf16*)(a.ws + WS_P); float* E = (float*)(a.ws + WS_SSME);
    LAS unsigned char* wl = F.lds + F.wave * SSM_WREG;
    const int lane = F.lane, fr = lane & 15, fq = lane >> 4;
    for (int task = F.bid + F.G * F.wave; task < BP * 16 * 32; task += F.G * NWAVES) {
        const int b = task >> 9, g = (task >> 5) & 15, sc = task & 31;
        const float ar = ((const float*)(sm + S_AB))[(g * 64 + lane) * 2], ai = ((const float*)(sm + S_AB))[(g * 64 + lane) * 2 + 1];
        bf16x8 bb[8]; ssm_load_bb((const bf16*)(sm + S_BBART), g, lane, bb);
        float sr = 0.f, si = 0.f;
        const bf16* up = P + (size_t)(b * TP + sc * 128 + fr) * INW + g * 16 + 8 * fq;
        bf16x8 un[4];
#pragma unroll
        for (int k = 0; k < 4; ++k) un[k] = (fq < 2) ? ld8g(up + (size_t)(16 * k) * INW) : zero8();
        for (int sub = 0; sub < 2; ++sub) {
            bf16x8 uc[4];
#pragma unroll
            for (int k = 0; k < 4; ++k) uc[k] = un[k];
            if (sub < 1) {
#pragma unroll
                for (int k = 0; k < 4; ++k) un[k] = (fq < 2) ? ld8g(up + (size_t)(64 * (sub + 1) + 16 * k) * INW) : zero8(); }
#pragma unroll
            for (int k = 0; k < 4; ++k) ssm_block16<false>(wl, uc[k], bb, ar, ai, sr, si, lane);
            { const unsigned long long ev = (unsigned long long)__builtin_bit_cast(unsigned, sr) | ((unsigned long long)__builtin_bit_cast(unsigned, si) << 32);
              __hip_atomic_store((GAS unsigned long long*)(E + ((((size_t)(b * 32 + sc) * 2 + sub) * 16 + g) * 64 + lane) * 2), ev, RLX_AGENT); }
        }
    }
}
DI void ssm_pass2_unit(const Args& a, const Frame& F, int l, int unit) {
    const unsigned char* sm = a.ws + WS_W + (size_t)l * LW + W_SMALL;
    const bf16* P = (const bf16*)(a.ws + WS_P); const float* E = (const float*)(a.ws + WS_SSME); bf16* MIX = (bf16*)(a.ws + WS_MIX);
    int lane = F.lane; asm volatile("" : "+v"(lane));
    const int fr = lane & 15, fq = lane >> 4;
    const bool prompt = unit < 256; const int b = prompt ? (unit >> 6) : (unit - 256), ck = prompt ? (unit & 63) : 0;
    const int row0 = prompt ? b * TP + ck * 64 : NP + b * 64;
    LAS unsigned char* wl = F.lds + F.wave * SSM_WREG; LAS bf16* G = (LAS bf16*)(F.lds + SSM_G);
    for (int gi = 0; gi < 2; ++gi) {
        const int g = 2 * F.wave + gi;
        const float ar = ((const float*)(sm + S_AB))[(g * 64 + lane) * 2], ai = ((const float*)(sm + S_AB))[(g * 64 + lane) * 2 + 1];
        float sr, si;
        if (prompt) {
            const int sc = ck >> 1, sub = ck & 1;
            const float a128r = ((const float*)(sm + S_A256))[(g * 64 + lane) * 2], a128i = ((const float*)(sm + S_A256))[(g * 64 + lane) * 2 + 1];
            sr = 0.f; si = 0.f;
#pragma unroll
            for (int hb = 0; hb < 2; ++hb) {
                float er[16], ei[16];
#pragma unroll
                for (int j = 0; j < 16; ++j) { const int jj = hb * 16 + j; const float* e = E + ((((size_t)(b * 32 + (jj < 31 ? jj : 30)) * 2 + 1) * 16 + g) * 64 + lane) * 2; er[j] = e[0]; ei[j] = e[1]; }
#pragma unroll
                for (int j = 0; j < 16; ++j) { const float nr = a128r * sr - a128i * si + er[j], ni = a128r * si + a128i * sr + ei[j]; if (hb * 16 + j < sc) { sr = nr; si = ni; } }
            }
            if (sub > 0) {
                const float a64r = ((const float*)(sm + S_A64))[(g * 64 + lane) * 2], a64i = ((const float*)(sm + S_A64))[(g * 64 + lane) * 2 + 1];
                const float* e = E + ((((size_t)(b * 32 + sc) * 2 + 0) * 16 + g) * 64 + lane) * 2;
                const float nr = a64r * sr - a64i * si + e[0], ni = a64r * si + a64i * sr + e[1]; sr = nr; si = ni; }
        } else {
            sr = a.in[I_SRE][((size_t)(l * BS + b) * 16 + g) * 64 + lane]; si = a.in[I_SIM][((size_t)(l * BS + b) * 16 + g) * 64 + lane];
        }
        bf16x8 bb[8]; ssm_load_bb((const bf16*)(sm + S_BBART), g, lane, bb);
        bf16x8 cm[4];
#pragma unroll
        for (int ks = 0; ks < 4; ++ks) cm[ks] = ld8g((const bf16*)(sm + S_CMT) + (size_t)(g * 16 + fr) * 128 + 32 * ks + 8 * fq);
        bf16x8 df; { const unsigned short dv = (unsigned short)f2bf(a.in[I_SD][l * 256 + g * 16 + fr]);
#pragma unroll
            for (int j = 0; j < 8; ++j) df[j] = (fq < 2 && 8 * fq + j == fr) ? (short)dv : (short)0; }
        const bf16* up = P + (size_t)(row0 + fr) * INW + g * 16 + 8 * fq;
        bf16x8 uc[4];
#pragma unroll
        for (int k = 0; k < 4; ++k) uc[k] = (fq < 2) ? ld8g(up + (size_t)(16 * k) * INW) : zero8();
#pragma unroll
        for (int k = 0; k < 4; ++k) {
            ssm_block16<true>(wl, uc[k], bb, ar, ai, sr, si, lane);
            f32x4 y = (f32x4){0.f, 0.f, 0.f, 0.f};
#pragma unroll
            for (int ks = 0; ks < 4; ++ks) y = MFMA16(ld8l(wl + SSM_S + (fr * 136 + 32 * ks + 8 * fq) * 2), cm[ks], y);
            y = MFMA16(uc[k], df, y);
#pragma unroll
            for (int j = 0; j < 4; ++j) G[(16 * k + 4 * fq + j) * 264 + g * 16 + fr] = (bf16)f2bf(gelu_tanh(y[j]));
        }
        if (!prompt || ck == 63) {
            float* orp = prompt ? a.out + O_PSR + ((size_t)(l * BP + b) * 16 + g) * 64 : a.out + O_SSR + ((size_t)(l * BS + b) * 16 + g) * 64;
            float* oip = prompt ? a.out + O_PSI + ((size_t)(l * BP + b) * 16 + g) * 64 : a.out + O_SSI + ((size_t)(l * BS + b) * 16 + g) * 64;
            orp[lane] = sr; oip[lane] = si; }
    }
    __syncthreads();
    f32x4 acc[4][2];
    mm64((const LAS unsigned char*)G, 528, (const bf16*)(sm + S_WGLU), F.wave, lane, acc);
#pragma unroll
    for (int ct = 0; ct < 2; ++ct) { const int n = 32 * F.wave + 16 * ct + fr; const float bg = a.in[I_BGLU][l * 256 + n];
#pragma unroll
        for (int rt = 0; rt < 4; ++rt)
#pragma unroll
            for (int j = 0; j < 4; ++j) { const int t = 16 * rt + 4 * fq + j; const float gv = bf2f(G[t * 264 + n]);
                ((LAS bf16*)F.lds)[t * 264 + n] = (bf16)f2bf(gv * sigmoidf_(acc[rt][ct][j] + bg)); } }
    __syncthreads();
#pragma unroll
    for (int k = 0; k < 4; ++k) { const int e = F.tid + k * NTHR, t = e >> 5, c8 = (e & 31) * 8;
        *(u32x4*)(MIX + (size_t)(row0 + t) * DM + c8) = *(const LAS u32x4*)((LAS bf16*)F.lds + t * 264 + c8); }
}

constexpr int CV_Z = 0, CV_Y = 49152, CV_A = 0;
DI void conv_unit(const Args& a, const Frame& F, int l, int unit) {
    const unsigned char* sm = a.ws + WS_W + (size_t)l * LW + W_SMALL;
    const bf16* P = (const bf16*)(a.ws + WS_P); bf16* MIX = (bf16*)(a.ws + WS_MIX);
    int lane = F.lane, tid = F.tid;
    asm volatile("" : "+v"(lane), "+v"(tid));
    const bool prompt = unit < 256; const int b = prompt ? (unit >> 6) : (unit - 256), tt = prompt ? (unit & 63) : 0;
    const int row0 = prompt ? b * TP + tt * 64 : NP + b * 64;
    LAS bf16* Z = (LAS bf16*)(F.lds + CV_Z); LAS float* Y = (LAS float*)(F.lds + CV_Y);
    const bool wbuf = !prompt || tt == 63;
    float* obuf = prompt ? a.out + O_PCV + (size_t)(l * BP + b) * 30 * 256 : a.out + O_SCV + (size_t)(l * BS + b) * 30 * 256;
    float w[31];
#pragma unroll
    for (int k = 0; k < 31; ++k) w[k] = a.in[I_CW][((size_t)l * 31 + k) * 256 + (tid & 255)];
    const float cb = a.in[I_CB][l * 256 + (tid & 255)];
    bf16x8 bfr[2][8]; mm64_loadb((const bf16*)(sm + S_WPW), F.wave, lane, bfr);
    const bool first = !prompt || tt == 0;
    if (first) {
        for (int e = tid; e < 30 * 32; e += NTHR) { const int i = e >> 5, c8 = (e & 31) * 8;
            u32x4 w = (u32x4){0u, 0u, 0u, 0u};
            if (!prompt) { const f32x4* sp = (const f32x4*)(a.in[I_SCONV] + ((size_t)(l * BS + b) * 30 + i) * 256 + c8); w = pack8(sp[0], sp[1]); }
            *(LAS u32x4*)(Z + i * 256 + c8) = w; }
    }
    {
        const int i0 = first ? 30 : 0, nch = (94 - i0) * 32;
        for (int eb = 0; eb < nch; eb += 3 * NTHR) {
            u32x4 av[3], gv[3];
#pragma unroll
            for (int r = 0; r < 3; ++r) { int e = eb + r * NTHR + tid; e = e < nch ? e : nch - 1; const int i = i0 + (e >> 5), c8 = (e & 31) * 8;
                const bf16* pr = P + (size_t)(row0 - 30 + i) * INW + 1024 + c8; av[r] = *(const u32x4*)pr; gv[r] = *(const u32x4*)(pr + 256); }
#pragma unroll
            for (int r = 0; r < 3; ++r) { const int e = eb + r * NTHR + tid; if (e < nch) { const int i = i0 + (e >> 5), c8 = (e & 31) * 8;
                float z[8];
#pragma unroll
                for (int q = 0; q < 4; ++q) { z[2 * q] = bflo(av[r][q]) * sigmoidf_(bflo(gv[r][q])); z[2 * q + 1] = bfhi(av[r][q]) * sigmoidf_(bfhi(gv[r][q])); }
                u32x4 w; w.x = pk2(z[0], z[1]); w.y = pk2(z[2], z[3]); w.z = pk2(z[4], z[5]); w.w = pk2(z[6], z[7]);
                *(LAS u32x4*)(Z + i * 256 + c8) = w;
                if (wbuf && i >= 64) { f32x4* o = (f32x4*)(obuf + (size_t)(i - 64) * 256 + c8); o[0] = (f32x4){z[0], z[1], z[2], z[3]}; o[1] = (f32x4){z[4], z[5], z[6], z[7]}; } } }
        }
    }
    __syncthreads();
    {
        const int c = tid & 255, th = tid >> 8;
#pragma unroll 1
        for (int tg = 0; tg < 8; ++tg) { const int t = th * 32 + tg * 4;
            float zz[34];
#pragma unroll
            for (int k = 0; k < 34; ++k) zz[k] = bf2f(Z[(t + k) * 256 + c]);
#pragma unroll
            for (int q = 0; q < 4; ++q) { float s = cb;
#pragma unroll
                for (int k = 0; k < 31; ++k) s += w[k] * zz[k + q];
                Y[(t + q) * 260 + c] = s; } }
    }
    __syncthreads();
    {
        const f32x4 lg = ((const f32x4*)(a.in[I_CLG] + l * 256))[lane], lb = ((const f32x4*)(a.in[I_CLB] + l * 256))[lane];
        LAS unsigned char* A = F.lds + CV_A;
        f32x4 v[8]; float st[16];
#pragma unroll
        for (int r = 0; r < 8; ++r) { v[r] = *(const LAS f32x4*)(Y + (8 * F.wave + r) * 260 + 4 * lane);
            st[r] = (v[r][0] + v[r][1]) + (v[r][2] + v[r][3]); st[8 + r] = (v[r][0] * v[r][0] + v[r][1] * v[r][1]) + (v[r][2] * v[r][2] + v[r][3] * v[r][3]); }
        wave_sum_n<16>(st);
#pragma unroll
        for (int r = 0; r < 8; ++r) { const int t = 8 * F.wave + r; const float mu = st[r] * (1.f / 256.f); const float var = fmaxf(st[8 + r] * (1.f / 256.f) - mu * mu, 0.f); const float rstd = 1.f / sqrtf(var + EPS);
            f32x4 o;
#pragma unroll
            for (int q = 0; q < 4; ++q) o[q] = siluf_((v[r][q] - mu) * rstd * lg[q] + lb[q]);
            u32x2 wv; wv.x = pk2(o[0], o[1]); wv.y = pk2(o[2], o[3]); *(LAS u32x2*)(A + t * 528 + lane * 8) = wv; }
    }
    __syncthreads();
    f32x4 acc[4][2];
    mm64_compute(F.lds + CV_A, 528, bfr, lane, acc);
    const int fr = lane & 15, fq = lane >> 4;
#pragma unroll
    for (int ct = 0; ct < 2; ++ct) { const int n = 32 * F.wave + 16 * ct + fr;
#pragma unroll
        for (int rt = 0; rt < 4; ++rt)
#pragma unroll
            for (int j = 0; j < 4; ++j) ((LAS bf16*)(F.lds + CV_Y))[(16 * rt + 4 * fq + j) * 264 + n] = (bf16)f2bf(acc[rt][ct][j]); }
    __syncthreads();
#pragma unroll
    for (int k = 0; k < 4; ++k) { const int e = tid + k * NTHR, t = e >> 5, c8 = (e & 31) * 8;
        *(u32x4*)(MIX + (size_t)(row0 + t) * DM + 512 + c8) = *(const LAS u32x4*)((LAS bf16*)(F.lds + CV_Y) + t * 264 + c8); }
}

template <int L>
DI void gmlp_unit_t(const Args& a, const Frame& F, int l, int row0, float* gv_out) {
    const unsigned char* sm = a.ws + WS_W + (size_t)l * LW + W_SMALL;
    const bf16* P = (const bf16*)(a.ws + WS_P); bf16* MIX = (bf16*)(a.ws + WS_MIX);
    const int lane = F.lane, fr = lane & 15, fq = lane >> 4;
    LAS unsigned char* VL = F.lds;
    const int h = F.wave >> 1; const bf16* Wm = (const bf16*)(sm + S_GMLPW) + (size_t)h * 128 * 128;
    bf16x8 af[L / 32][L / 32]; float bsv[L / 32][4];
#pragma unroll
    for (int r = 0; r < L / 32; ++r) { const int it = (F.wave & 1) * (L / 32) + r;
#pragma unroll
        for (int ks = 0; ks < L / 32; ++ks) { const bf16* wr_ = Wm + (size_t)(16 * it + fr) * 128 + 32 * ks + 4 * fq; af[r][ks] = cat44(*(const u32x2*)wr_, *(const u32x2*)(wr_ + 16)); }
#pragma unroll
        for (int j = 0; j < 4; ++j) bsv[r][j] = a.in[I_GBS][(l * 4 + h) * 128 + 16 * it + 4 * fq + j]; }
    {
        const f32x4 lg = ((const f32x4*)(a.in[I_GLG] + l * 256))[lane], lb = ((const f32x4*)(a.in[I_GLB] + l * 256))[lane];
        for (int t0 = F.wave; t0 < L; t0 += 4 * NWAVES) {
            u32x2 raw[4];
#pragma unroll
            for (int r = 0; r < 4; ++r) raw[r] = *(const u32x2*)(P + (size_t)(row0 + t0 + r * NWAVES) * INW + 1792 + 4 * lane);
            f32x4 v[4]; float st[8];
#pragma unroll
            for (int r = 0; r < 4; ++r) { v[r] = (f32x4){bflo(raw[r].x), bfhi(raw[r].x), bflo(raw[r].y), bfhi(raw[r].y)};
                st[r] = (v[r][0] + v[r][1]) + (v[r][2] + v[r][3]); st[4 + r] = (v[r][0] * v[r][0] + v[r][1] * v[r][1]) + (v[r][2] * v[r][2] + v[r][3] * v[r][3]); }
            wave_sum_n<8>(st);
#pragma unroll
            for (int r = 0; r < 4; ++r) { const int t = t0 + r * NWAVES;
                const float mu = st[r] * (1.f / 256.f); const float var = fmaxf(st[4 + r] * (1.f / 256.f) - mu * mu, 0.f); const float rstd = 1.f / sqrtf(var + EPS);
                const f32x4 o = (v[r] - mu) * rstd * lg + lb;
                if (gv_out) *(f32x4*)(gv_out + (size_t)t * 256 + 4 * lane) = o;
                u32x2 wv; wv.x = pk2(o[0], o[1]); wv.y = pk2(o[2], o[3]); *(LAS u32x2*)(VL + t * 544 + lane * 8) = wv; }
        }
    }
    __syncthreads();
    constexpr int NRT = L / 32;
    LAS bf16* MX = (LAS bf16*)(F.lds + 69632);
#pragma unroll
    for (int r = 0; r < NRT; ++r) {
        const int it = (F.wave & 1) * NRT + r, ksn = it / 2 + 1;
        f32x4 acc[4];
#pragma unroll
        for (int dt = 0; dt < 4; ++dt) acc[dt] = (f32x4){0.f, 0.f, 0.f, 0.f};
#pragma unroll
        for (int ks = 0; ks < L / 32; ++ks) if (ks < ksn) {
#pragma unroll
            for (int dt = 0; dt < 4; ++dt) { const LAS unsigned char* vr = VL + (32 * ks + 4 * fq + (fr >> 2)) * 544 + (h * 64 + 16 * dt + 4 * (fr & 3)) * 2;
                acc[dt] = MFMA16(af[r][ks], cat44(tr4(vr), tr4(vr + 16 * 544)), acc[dt]); } }
#pragma unroll
        for (int j = 0; j < 4; ++j) { const int i = 16 * it + 4 * fq + j;
#pragma unroll
            for (int dt = 0; dt < 4; ++dt) MX[i * 264 + h * 64 + 16 * dt + fr] = (bf16)f2bf(acc[dt][j] + bsv[r][j]); }
    }
    __syncthreads();
    {
        constexpr int NCH = L * 32 / NTHR;
        u32x4 uv[NCH];
#pragma unroll
        for (int k = 0; k < NCH; ++k) { const int e = F.tid + k * NTHR, i = e >> 5, c8 = (e & 31) * 8; uv[k] = *(const u32x4*)(P + (size_t)(row0 + i) * INW + 1536 + c8); }
#pragma unroll
        for (int k = 0; k < NCH; ++k) { const int e = F.tid + k * NTHR, i = e >> 5, c8 = (e & 31) * 8; const u32x4 mv = *(const LAS u32x4*)(MX + i * 264 + c8);
            u32x4 o;
#pragma unroll
            for (int q = 0; q < 4; ++q) o[q] = pk2(bflo(uv[k][q]) * bflo(mv[q]), bfhi(uv[k][q]) * bfhi(mv[q]));
            *(u32x4*)(MIX + (size_t)(row0 + i) * DM + 768 + c8) = o; }
    }
}
DI void gmlp_unit(const Args& a, const Frame& F, int l, int unit) {
    if (unit < 128) gmlp_unit_t<128>(a, F, l, (unit >> 5) * TP + (unit & 31) * 128, nullptr);
    else { const int b = unit - 128; gmlp_unit_t<64>(a, F, l, NP + b * 64, a.out + O_SGV + (size_t)(l * BS + b) * 64 * 256); }
}

constexpr int AT_K = 0, AT_V = 17408, AT_BUF = 35840;
struct AtRaw { f32x4 k[2][2], v[2][2]; };
DI void at_issue(AtRaw& r, const void* kp, const void* vp, size_t rowstride_b, bool f32src, int tid) {
#pragma unroll
    for (int c = 0; c < 2; ++c) { const int e = tid + c * NTHR, key = e >> 4, c8 = (e & 15) * 8;
        const char* k0 = (const char*)kp + key * rowstride_b + (f32src ? c8 * 4 : c8 * 2); const char* v0 = (const char*)vp + key * rowstride_b + (f32src ? c8 * 4 : c8 * 2);
        const int o2 = f32src ? 16 : 0;
        r.k[c][0] = *(const f32x4*)k0; r.k[c][1] = *(const f32x4*)(k0 + o2); r.v[c][0] = *(const f32x4*)v0; r.v[c][1] = *(const f32x4*)(v0 + o2); }
}
DI void at_commit(const AtRaw& r, LAS unsigned char* buf, bool f32src, int tid) {
#pragma unroll
    for (int c = 0; c < 2; ++c) { const int e = tid + c * NTHR, key = e >> 4, c8 = (e & 15) * 8;
        const u32x4 kc = pack8(r.k[c][0], r.k[c][1]), vc = pack8(r.v[c][0], r.v[c][1]);
        const u32x4 kb = __builtin_bit_cast(u32x4, r.k[c][0]), vb = __builtin_bit_cast(u32x4, r.v[c][0]);
        u32x4 kw, vw;
#pragma unroll
        for (int q = 0; q < 4; ++q) { kw[q] = f32src ? kc[q] : kb[q]; vw[q] = f32src ? vc[q] : vb[q]; }
        *(LAS u32x4*)(buf + AT_K + key * 272 + c8 * 2) = kw;
        *(LAS u32x4*)(buf + AT_V + key * 288 + c8 * 2) = vw; }
}
DI void at_src(int kt, int nf32, const float* ck, const float* cv, const bf16* P, int prow0, int hp, const void*& kp, const void*& vp, size_t& rs, bool& f32s) {
    if (kt < nf32) { kp = ck + (size_t)(kt * 64) * 256 + hp * 128; vp = cv + (size_t)(kt * 64) * 256 + hp * 128; rs = 1024; f32s = true; }
    else { const bf16* pb = P + (size_t)(prow0 + (kt - nf32) * 64) * INW + hp * 128; kp = pb + 512; vp = pb + 768; rs = INW * 2; f32s = false; }
}
struct AtRawB { u32x4 k[2], v[2]; };
DI void atb_issue(AtRawB& r, const char* tb, unsigned voff) {
#pragma unroll
    for (int c = 0; c < 2; ++c) { const char* p = tb + (voff + (unsigned)c * (32u * INW * 2u));
        r.k[c] = *(const u32x4*)p; r.v[c] = *(const u32x4*)(p + 512); }
}
DI void atb_commit(const AtRawB& r, LAS unsigned char* buf, int tid) {
#pragma unroll
    for (int c = 0; c < 2; ++c) { const int e = tid + c * NTHR, key = e >> 4, c8 = (e & 15) * 8;
        *(LAS u32x4*)(buf + AT_K + key * 272 + c8 * 2) = r.k[c]; *(LAS u32x4*)(buf + AT_V + key * 288 + c8 * 2) = r.v[c]; }
}
struct AtState { float ref, l1, l2; f32x4 O1[4], O2[4], cinit[4]; };
DI void at_qk(f32x4 (&s1)[4], f32x4 (&s2)[4], const LAS unsigned char* buf, const bf16x8 q1, const bf16x8 q2, const f32x4 (&ci)[4], int hh, int fr, int fq) {
#pragma unroll
    for (int k4 = 0; k4 < 4; ++k4) { const LAS unsigned char* kr = buf + AT_K + (16 * k4 + fr) * 272 + hh * 128 + fq * 16;
        s1[k4] = MFMA16(ld8l(kr), q1, ci[k4]); s2[k4] = MFMA16(ld8l(kr + 64), q2, ci[k4]); }
}
DI void at_exp(f32x4 (&s1)[4], f32x4 (&s2)[4], float& ps1, float& ps2) {
    f32x4 a1 = (f32x4){0.f, 0.f, 0.f, 0.f}, a2 = a1;
#pragma unroll
    for (int k4 = 0; k4 < 4; ++k4) {
#pragma unroll
        for (int j = 0; j < 4; ++j) { s1[k4][j] = fast_exp2(s1[k4][j]); s2[k4][j] = fast_exp2(s2[k4][j]); }
        a1 = a1 + s1[k4]; a2 = a2 + s2[k4]; }
    ps1 = (a1[0] + a1[1]) + (a1[2] + a1[3]); ps2 = (a2[0] + a2[1]) + (a2[2] + a2[3]);
}
DI void at_pv(AtState& S, const f32x4 (&s1)[4], const f32x4 (&s2)[4], float alpha, float ps1, float ps2, const LAS unsigned char* buf, int hh, int fq, int tq, int tp) {
    S.l1 = S.l1 * alpha + ps1; S.l2 = S.l2 * alpha + ps2;
#pragma unroll
    for (int dt = 0; dt < 4; ++dt) { S.O1[dt] = S.O1[dt] * alpha; S.O2[dt] = S.O2[dt] * alpha; }
    bf16x8 p1[2], p2[2];
#pragma unroll
    for (int s = 0; s < 2; ++s) { p1[s] = packp(s1[2 * s], s1[2 * s + 1]); p2[s] = packp(s2[2 * s], s2[2 * s + 1]); }
#pragma unroll
    for (int dh = 0; dh < 2; ++dh) {
        bf16x8 vt[2][2];
#pragma unroll
        for (int d2 = 0; d2 < 2; ++d2)
#pragma unroll
            for (int s = 0; s < 2; ++s) { const int dt = 2 * dh + d2; const LAS unsigned char* vr = buf + AT_V + (32 * s + 4 * fq + tq) * 288 + (hh * 64 + 16 * dt + 4 * tp) * 2; vt[d2][s] = cat44(tr4(vr), tr4(vr + 16 * 288)); }
        __builtin_amdgcn_s_setprio(1);
#pragma unroll
        for (int s = 0; s < 2; ++s)
#pragma unroll
            for (int d2 = 0; d2 < 2; ++d2) { const int dt = 2 * dh + d2; S.O1[dt] = MFMA16(vt[d2][s], p1[s], S.O1[dt]); S.O2[dt] = MFMA16(vt[d2][s], p2[s], S.O2[dt]); }
        __builtin_amdgcn_s_setprio(0);
        __builtin_amdgcn_sched_barrier(0);
    }
}
template <int VAR>
DI void attn_tile(AtState& S, const LAS unsigned char* buf, const bf16x8 q1, const bf16x8 q2, int kt, bool diag, int qpos0, int qpos_l, float slope2, float adv, float decay, int hh, int fr, int fq) {
    const int tq = fr >> 2, tp = fr & 3;
    const bool exact = diag || kt == 0;
    f32x4 s1[4], s2[4]; float ps1, ps2;
    if (exact) {
        asm volatile("; attention: exact tile" ::: "memory");
        { f32x4 z[4];
#pragma unroll
          for (int k4 = 0; k4 < 4; ++k4) z[k4] = (f32x4){0.f, 0.f, 0.f, 0.f};
          at_qk(s1, s2, buf, q1, q2, z, hh, fr, fq); }
        int ql = qpos_l - 4 * fq; asm volatile("" : "+v"(ql));
        const float dk = slope2 * (float)(qpos0 - kt * 64);
        float mx = -1e30f;
#pragma unroll
        for (int k4 = 0; k4 < 4; ++k4)
#pragma unroll
            for (int j = 0; j < 4; ++j) { const float g = slope2 * (float)(16 * k4 + j - ql); const float bias = diag ? -fabsf(g) : g - dk;
                s1[k4][j] += bias; s2[k4][j] += bias; mx = fmaxf(mx, fmaxf(s1[k4][j], s2[k4][j])); }
        mx = fmaxf(mx, __shfl_xor(mx, 16)); mx = fmaxf(mx, __shfl_xor(mx, 32));
        const float nref = fmaxf(S.ref, mx);
        const float alpha = fast_exp2(S.ref - nref); S.ref = nref;
#pragma unroll
        for (int k4 = 0; k4 < 4; ++k4) { s1[k4] = s1[k4] - nref; s2[k4] = s2[k4] - nref; }
        if (kt == 0) { const float c0 = -slope2 * (float)qpos0 - S.ref;
#pragma unroll
            for (int k4 = 0; k4 < 4; ++k4)
#pragma unroll
                for (int j = 0; j < 4; ++j) S.cinit[k4][j] = slope2 * (float)(16 * k4 + j - ql) + c0; }
        at_exp(s1, s2, ps1, ps2);
        at_pv(S, s1, s2, alpha, ps1, ps2, buf, hh, fq, tq, tp);
    } else {
        asm volatile("; attention: fast tile" ::: "memory");
        at_qk(s1, s2, buf, q1, q2, S.cinit, hh, fr, fq);
        S.ref += adv;
        at_exp(s1, s2, ps1, ps2);
        if (__any(!(ps1 + ps2 < 0x1p60f))) {
            asm volatile("; attention: bump" ::: "memory");
            at_qk(s1, s2, buf, q1, q2, S.cinit, hh, fr, fq);
            float lm = -1e30f;
#pragma unroll
            for (int k4 = 0; k4 < 4; ++k4)
#pragma unroll
                for (int j = 0; j < 4; ++j) lm = fmaxf(lm, fmaxf(s1[k4][j], s2[k4][j]));
            lm = fmaxf(lm, __shfl_xor(lm, 16)); lm = fmaxf(lm, __shfl_xor(lm, 32));
            const float bump = fmaxf(lm, 0.f);
            const float alpha = decay * fast_exp2(-bump); S.ref += bump;
#pragma unroll
            for (int k4 = 0; k4 < 4; ++k4) { s1[k4] = s1[k4] - bump; s2[k4] = s2[k4] - bump; S.cinit[k4] = S.cinit[k4] - bump; }
            at_exp(s1, s2, ps1, ps2);
            at_pv(S, s1, s2, alpha, ps1, ps2, buf, hh, fq, tq, tp);
        } else {
            asm volatile("; attention: fast tail" ::: "memory");
            at_pv(S, s1, s2, decay, ps1, ps2, buf, hh, fq, tq, tp);
        }
    }
}
template <int VAR>
DI void attn_segment(const Args& a, const Frame& F, int l, int qrow0, int qpos0, int hp, int ntile, int nf32, const float* ck, const float* cv, int prow0) {
    const unsigned char* sm = a.ws + WS_W + (size_t)l * LW + W_SMALL;
    const bf16* P = (const bf16*)(a.ws + WS_P); bf16* MIX = (bf16*)(a.ws + WS_MIX);
    int lane = F.lane, tid = F.tid, wave = F.wave;
    asm volatile("" : "+v"(lane), "+v"(tid)); asm volatile("" : "+s"(wave));
    const int fr = lane & 15, fq = lane >> 4;
    const int hh = wave >> 2, h = 2 * hp + hh, qr = (wave & 3) * 16;
    const float slope2 = exp2f(-2.f * (float)(h + 1)) * LOG2E;
    const bf16* qp = P + (size_t)(qrow0 + qr + fr) * INW + 256 + h * 64 + 8 * fq;
    const bf16x8 q1 = ld8g(qp), q2 = ld8g(qp + 32);
    const int qpos_l = qr + fr;
    const float adv = 64.f * slope2, decay = fast_exp2(-adv);
    AtState S; S.ref = -1e30f; S.l1 = 0.f; S.l2 = 0.f;
#pragma unroll
    for (int dt = 0; dt < 4; ++dt) { S.O1[dt] = (f32x4){0.f, 0.f, 0.f, 0.f}; S.O2[dt] = (f32x4){0.f, 0.f, 0.f, 0.f};
#pragma unroll
        for (int j = 0; j < 4; ++j) S.cinit[dt][j] = 0.f; }
    if (nf32 == 0) {
        const char* pb = (const char*)(P + (size_t)prow0 * INW + 512 + hp * 128);
        const unsigned voff = (unsigned)((tid >> 4) * INW + (tid & 15) * 8) * 2u; constexpr size_t TSTR = (size_t)64 * INW * 2;
        AtRawB ra, rb;
        atb_issue(ra, pb, voff); atb_commit(ra, F.lds, tid);
        const int nl = ntile - 1;
        atb_issue(ra, pb + (size_t)(nl < 1 ? nl : 1) * TSTR, voff);
        lds_barrier();
        for (int kt = 0; kt < ntile; kt += 2) {
            atb_issue(rb, pb + (size_t)(kt + 2 < nl ? kt + 2 : nl) * TSTR, voff);
            attn_tile<VAR>(S, F.lds + (kt & 1) * AT_BUF, q1, q2, kt, kt + 1 == ntile, qpos0, qpos_l, slope2, adv, decay, hh, fr, fq);
            atb_commit(ra, F.lds + ((kt + 1) & 1) * AT_BUF, tid);
            lds_barrier();
            if (kt + 1 >= ntile) break;
            atb_issue(ra, pb + (size_t)(kt + 3 < nl ? kt + 3 : nl) * TSTR, voff);
            attn_tile<VAR>(S, F.lds + ((kt + 1) & 1) * AT_BUF, q1, q2, kt + 1, kt + 2 == ntile, qpos0, qpos_l, slope2, adv, decay, hh, fr, fq);
            atb_commit(rb, F.lds + (kt & 1) * AT_BUF, tid);
            lds_barrier();
        }
    } else {
        AtRaw raw;
        { const void *kp, *vp; size_t rs; bool f32s; at_src(0, nf32, ck, cv, P, prow0, hp, kp, vp, rs, f32s); at_issue(raw, kp, vp, rs, f32s, tid); at_commit(raw, F.lds, f32s, tid); }
        lds_barrier();
        for (int kt = 0; kt < ntile; ++kt) {
            const bool more = kt + 1 < ntile; bool nf32s = false;
            if (more) { const void *kp, *vp; size_t rs; at_src(kt + 1, nf32, ck, cv, P, prow0, hp, kp, vp, rs, nf32s); at_issue(raw, kp, vp, rs, nf32s, tid); }
            attn_tile<VAR>(S, F.lds + (kt & 1) * AT_BUF, q1, q2, kt, !more, qpos0, qpos_l, slope2, adv, decay, hh, fr, fq);
            if (more) at_commit(raw, F.lds + ((kt + 1) & 1) * AT_BUF, nf32s, tid);
            lds_barrier();
        }
    }
    float l1 = S.l1, l2 = S.l2;
    l1 += __shfl_xor(l1, 16); l1 += __shfl_xor(l1, 32); l2 += __shfl_xor(l2, 16); l2 += __shfl_xor(l2, 32);
    const float lam = ((const float*)(sm + S_LAM))[0], lam_init = ((const float*)(sm + S_LAM))[1];
    const float i1 = 1.f / l1, i2 = lam / l2;
    float ss = 0.f;
#pragma unroll
    for (int dt = 0; dt < 4; ++dt)
#pragma unroll
        for (int j = 0; j < 4; ++j) { const float o = S.O1[dt][j] * i1 - S.O2[dt][j] * i2; S.O1[dt][j] = o; ss += o * o; }
    ss += __shfl_xor(ss, 16); ss += __shfl_xor(ss, 32);
    const float rs = (1.f - lam_init) / sqrtf(ss * (1.f / 64.f) + EPS);
    bf16* op = MIX + (size_t)(qrow0 + qr + fr) * DM + 256 + h * 64 + 4 * fq;
#pragma unroll
    for (int dt = 0; dt < 4; ++dt) { const f32x4 gn = *(const f32x4*)(a.in[I_DNORM] + l * 64 + 16 * dt + 4 * fq);
        u32x2 w; w.x = pk2(S.O1[dt][0] * rs * gn[0], S.O1[dt][1] * rs * gn[1]); w.y = pk2(S.O1[dt][2] * rs * gn[2], S.O1[dt][3] * rs * gn[3]);
        *(u32x2*)(op + 16 * dt) = w; }
}
constexpr int AT_UNITS = 576;
template <int VAR>
DI void attn_unit(const Args& a, const Frame& F, int l, int unit) {
    if (unit >= 112 && unit < 176) { const int u = unit - 112, b = u >> 1, hp = u & 1;
        attn_segment<VAR>(a, F, l, NP + b * 64, PAST, hp, 33, 32, a.in[I_CK] + (size_t)(l * BS + b) * PAST * 256, a.in[I_CV] + (size_t)(l * BS + b) * PAST * 256, NP + b * 64);
    } else { const int u = unit < 112 ? unit : unit - 64, c = 63 - (u >> 3), b = (u >> 1) & 3, hp = u & 1;
        attn_segment<VAR>(a, F, l, b * TP + c * 64, c * 64, hp, c + 1, 0, nullptr, nullptr, b * TP);
    }
}

constexpr int XA_K = 0, XA_V = 69632;
DI void xattn_unit(const Args& a, const Frame& F, int l, int unit) {
    const bf16* Q = (const bf16*)(a.ws + WS_Q); bf16* OX = (bf16*)(a.ws + WS_OX);
    int lane = F.lane, tid = F.tid; asm volatile("" : "+v"(lane), "+v"(tid));
    const int fr = lane & 15, fq = lane >> 4;
    const bool prompt = unit < 128;
    int b, h, row0, nrg;
    if (prompt) { b = unit >> 5; h = (unit >> 3) & 3; row0 = b * TP + (unit & 7) * 512; nrg = 32; }
    else { const int u = unit - 128; b = u >> 2; h = u & 3; row0 = NP + b * 64; nrg = 4; }
    bf16x8 qc[4];
    { const int rg = F.wave; const int row = row0 + 16 * (rg < nrg ? rg : 0) + fr;
#pragma unroll
      for (int ks = 0; ks < 4; ++ks) qc[ks] = ld8g(Q + (size_t)row * XW + h * 128 + 32 * ks + 8 * fq); }
    if (prompt) {
        const bf16* kb = (const bf16*)(a.ws + WS_MK) + ((size_t)l * (BP * NMEM) + b * NMEM) * XW + h * 128; const bf16* vb = (const bf16*)(a.ws + WS_MV) + ((size_t)l * (BP * NMEM) + b * NMEM) * XW + h * 128;
        u32x4 kr[8], vr[8];
#pragma unroll
        for (int i = 0; i < 8; ++i) { const int e = tid + i * NTHR, key = e >> 4, c8 = (e & 15) * 8; kr[i] = *(const u32x4*)(kb + (size_t)key * XW + c8); vr[i] = *(const u32x4*)(vb + (size_t)key * XW + c8); }
#pragma unroll
        for (int i = 0; i < 8; ++i) { const int e = tid + i * NTHR, key = e >> 4, c8 = (e & 15) * 8;
            *(LAS u32x4*)(F.lds + XA_K + key * 272 + c8 * 2) = kr[i]; *(LAS u32x4*)(F.lds + XA_V + key * 288 + c8 * 2) = vr[i]; }
    } else {
        const float* kb = a.in[I_CMK] + ((size_t)(l * BS + b) * NMEM * 4 + h) * 128; const float* vb = a.in[I_CMV] + ((size_t)(l * BS + b) * NMEM * 4 + h) * 128;
#pragma unroll
        for (int hb = 0; hb < 2; ++hb) {
            f32x4 kr[4][2], vr[4][2];
#pragma unroll
            for (int i = 0; i < 4; ++i) { const int e = tid + (hb * 4 + i) * NTHR, key = e >> 4, c8 = (e & 15) * 8; const f32x4* k4 = (const f32x4*)(kb + (size_t)key * 512 + c8); const f32x4* v4 = (const f32x4*)(vb + (size_t)key * 512 + c8);
                kr[i][0] = k4[0]; kr[i][1] = k4[1]; vr[i][0] = v4[0]; vr[i][1] = v4[1]; }
#pragma unroll
            for (int i = 0; i < 4; ++i) { const int e = tid + (hb * 4 + i) * NTHR, key = e >> 4, c8 = (e & 15) * 8;
                *(LAS u32x4*)(F.lds + XA_K + key * 272 + c8 * 2) = pack8(kr[i][0], kr[i][1]); *(LAS u32x4*)(F.lds + XA_V + key * 288 + c8 * 2) = pack8(vr[i][0], vr[i][1]); }
        }
    }
    __syncthreads();
#pragma unroll 1
    for (int rr = 0; rr < 4; ++rr) {
        const int rg = F.wave + rr * NWAVES; if (rg >= nrg) break;
        const int row = row0 + 16 * rg + fr;
        bf16x8 qn[4];
        { const int rgn = rg + NWAVES; const int rown = row0 + 16 * (rgn < nrg ? rgn : rg) + fr;
#pragma unroll
          for (int ks = 0; ks < 4; ++ks) qn[ks] = ld8g(Q + (size_t)rown * XW + h * 128 + 32 * ks + 8 * fq); }
        f32x4 sc[16];
#pragma unroll
        for (int k4 = 0; k4 < 4; ++k4) {
#pragma unroll
            for (int i = 0; i < 4; ++i) sc[4 * k4 + i] = (f32x4){0.f, 0.f, 0.f, 0.f};
#pragma unroll
            for (int ks = 0; ks < 4; ++ks)
#pragma unroll
                for (int i = 0; i < 4; ++i) { const int kb = 4 * k4 + i; sc[kb] = MFMA16(ld8l(F.lds + XA_K + (16 * kb + fr) * 272 + (32 * ks + 8 * fq) * 2), qc[ks], sc[kb]); }
        }
        float mx = max3f(sc[0][0], sc[0][1], sc[0][2]); mx = max3f(mx, sc[0][3], sc[0][3]);
#pragma unroll
        for (int kb = 1; kb < 16; ++kb) { mx = max3f(mx, sc[kb][0], sc[kb][1]); mx = max3f(mx, sc[kb][2], sc[kb][3]); }
        mx = fmaxf(mx, __shfl_xor(mx, 16)); mx = fmaxf(mx, __shfl_xor(mx, 32));
        f32x4 acc4 = (f32x4){0.f, 0.f, 0.f, 0.f};
        bf16x8 pf[8];
        f32x4 O[8];
#pragma unroll
        for (int dt = 0; dt < 8; ++dt) O[dt] = (f32x4){0.f, 0.f, 0.f, 0.f};
#pragma unroll
        for (int s8 = 0; s8 < 8; ++s8) {
            f32x4 e0 = sc[2 * s8] - mx, e1 = sc[2 * s8 + 1] - mx;
#pragma unroll
            for (int j = 0; j < 4; ++j) { e0[j] = fast_exp2(e0[j]); e1[j] = fast_exp2(e1[j]); }
            acc4 = acc4 + e0; acc4 = acc4 + e1;
            pf[s8] = packp(e0, e1);
#pragma unroll
            for (int dt = 0; dt < 8; ++dt) { const LAS unsigned char* vr = F.lds + XA_V + (32 * s8 + 4 * fq + (fr >> 2)) * 288 + (16 * dt + 4 * (fr & 3)) * 2;
                O[dt] = MFMA16(cat44(tr4(vr), tr4(vr + 16 * 288)), pf[s8], O[dt]); }
        }
        float ls = (acc4[0] + acc4[1]) + (acc4[2] + acc4[3]);
        ls += __shfl_xor(ls, 16); ls += __shfl_xor(ls, 32);
        const float inv = 1.f / ls;
        bf16* op = OX + (size_t)row * XW + h * 128 + 4 * fq;
#pragma unroll
        for (int dt = 0; dt < 8; ++dt) { const f32x4 o = O[dt] * inv; u32x2 w; w.x = pk2(o[0], o[1]); w.y = pk2(o[2], o[3]); *(u32x2*)(op + 16 * dt) = w; }
#pragma unroll
        for (int ks = 0; ks < 4; ++ks) qc[ks] = qn[ks];
    }
}
constexpr int PH_PER_LAYER = 15, PH_FINAL = 1 + DEPTH * PH_PER_LAYER, N_PHASES = PH_FINAL + 1;
#ifndef PHMASK
#define PHMASK 0xFFFF
#endif
#define PH_ON(k) (((PHMASK) >> (k)) & 1)
#ifndef PROBE_PMODE
#define PROBE_PMODE 0
#endif
#ifndef REPMASK
#define REPMASK 0
#endif
#define REPS(k) ((((REPMASK) >> (k)) & 1) ? 2 : 1)
#define REPBAR(k) do { if (rep + 1 < REPS(k)) xcd_barrier(bar); } while (0)
#ifndef MK_MULTI
#define MK_MULTI 0
#endif

DI void launder(Frame& F) { asm volatile("" : "+v"(F.tid), "+v"(F.lane)); asm volatile("" : "+s"(F.wave), "+s"(F.bid)); }
#define LAUNDER() do { launder(F); GAS unsigned char* _g = (GAS unsigned char*)ws; asm volatile("" : "+s"(_g)); ws = (unsigned char*)_g; } while (0)
__global__ void __launch_bounds__(NTHR, 2) fwd(Args args) {
    extern __shared__ __attribute__((aligned(16))) unsigned char lds_raw[];
    Frame F;
    F.lds = (LAS unsigned char*)lds_raw;
    F.MISC = (volatile LAS unsigned*)(F.lds + LDSCTL_OFF);
    F.tid = threadIdx.x; F.lane = F.tid & 63; F.wave = __builtin_amdgcn_readfirstlane(F.tid >> 6);
    F.G = gridDim.x; F.bid = blockIdx.x;
    F.ctl = (gu32*)(args.ws + WS_CTL);
    if (F.tid < 64) F.MISC[F.tid] = 0u;
    __syncthreads();
    XcdBarrier bar; bar.bar = (unsigned*)(F.ctl + CW_BAR); bar.x = 0; bar.st = nullptr;
    if (!MK_MULTI) bar = xcd_barrier_post((unsigned*)(F.ctl + CW_BAR), F.MISC + 8);
    const int lo = args.ph_lo, hi = args.ph_hi;
#define IN(k) (lo <= (k) && (k) < hi)
#define SEAM(k) do { if (IN(k) && IN((k) + 1)) xcd_barrier(bar); } while (0)
    unsigned char* ws = args.ws;
#define X ((float*)(ws + WS_X))
#define RSITE(k) ((float*)(ws + WS_RSTD) + (size_t)(k) * MT)
#define PSITE(k) ((float*)(ws + WS_SSP) + (size_t)(k) * MT * 16)
#define RS_LDS ((const LAS float*)(F.lds + LDS_RS))

    if (PH_ON(0) && IN(0)) for (int rep = 0; rep < REPS(0); ++rep) { LAUNDER(); prologue_weights(args, F, rep ? PROBE_PMODE : 0); if (rep == 0 || PROBE_PMODE == 0) { prologue_tables(args, F); memnorm_phase(args, F); } REPBAR(0); }
    SEAM(0);

    for (int l = 0; l < DEPTH; ++l) {
        const int pb = 1 + l * PH_PER_LAYER;
#define wl (ws + WS_W + (size_t)l * LW)
        if (PH_ON(1) && IN(pb + 0)) for (int rep = 0; rep < REPS(1); ++rep) { LAUNDER(); if (l == 0) norm_phase<1>(args, F, 0, 0.f, RSITE(0), nullptr); else norm_phase<0>(args, F, rep ? 0 : 8, 0.5f, RSITE(4 * l), PSITE(4 * l)); REPBAR(1); }
        SEAM(pb + 0);
        if (PH_ON(2) && IN(pb + 1)) for (int rep = 0; rep < REPS(2); ++rep) { LAUNDER(); pg8::Sched S{(const char*)(ws + WS_X), (const char*)(wl + W_GU1), DM, DM, MT / 256, 2 * DFF / 256, DM / 64, F.G, F.bid, nullptr, nullptr, 0, 0, 0, 0, 0};
            fill_rs_table(F, S, RSITE(4 * l)); EpiSwiGLU E{(bf16*)(ws + WS_ACT), RS_LDS}; pg8::gemm_phase<EpiSwiGLU, true>(F.lds, S, E, F.tid); REPBAR(2); }
        SEAM(pb + 1);
        if (PH_ON(3) && IN(pb + 2)) for (int rep = 0; rep < (REPS(3) > REPS(16) ? REPS(3) : REPS(16)); ++rep) { LAUNDER(); pg8::Sched S{(const char*)(ws + WS_ACT), (const char*)(wl + W_D1), ALD, ALD, NP / 256, DM / 256, DFF / 64, F.G, F.bid,
                                       (const char*)(ws + WS_ACT) + (size_t)NP * ALD * 2, (const char*)(wl + W_D1), NP / 256, (rep && REPS(20) > 1) ? 0 : NS / 256, DM / 256, 8, DFF / 64 / 8};
            EpiResid E{ws, rep ? 0.f : 0.5f, rep ? 16 : 4 * l + 1}; pg8::gemm_phase<EpiResid, true>(F.lds, S, E, F.tid); do { if (rep == 0 && (REPMASK & 0xF0008)) xcd_barrier(bar); } while (0); }
        SEAM(pb + 2);
        if (PH_ON(1) && IN(pb + 3)) for (int rep = 0; rep < REPS(1); ++rep) { LAUNDER(); norm_phase<0>(args, F, rep ? 0 : 8, 0.5f, RSITE(4 * l + 1), PSITE(4 * l + 1)); REPBAR(1); }
        SEAM(pb + 3);
#define WIN_EPI EpiWin E{(bf16*)(ws + WS_P), args.out + O_PK + (size_t)l * NP * 256, args.out + O_PV + (size_t)l * NP * 256, args.out + O_SK + (size_t)l * NS * 256, args.out + O_SV + (size_t)l * NS * 256, \
                     args.out + O_PMK + (size_t)l * BP * NMEM * XW, args.out + O_PMV + (size_t)l * BP * NMEM * XW, \
                     (bf16*)(ws + WS_MK) + (size_t)l * BP * NMEM * XW, (bf16*)(ws + WS_MV) + (size_t)l * BP * NMEM * XW, RS_LDS}
        if (PH_ON(4) && IN(pb + 4)) for (int rep = 0; rep < REPS(4); ++rep) { LAUNDER(); pg8::Sched S{(const char*)(ws + WS_X), (const char*)(wl + W_IN), DM, DM, MT / 256, INW / 256 - 1, DM / 64, F.G, F.bid, nullptr, nullptr, 0, 0, 0, 0, 0, 0};
            WIN_EPI; fill_rs_table(F, S, RSITE(4 * l + 1)); pg8::gemm_phase<EpiWin, true>(F.lds, S, E, F.tid); REPBAR(4); }
        SEAM(pb + 4);
        if (IN(pb + 5)) {
            if (PH_ON(4)) { LAUNDER(); pg8::Sched S{(const char*)(ws + WS_X), (const char*)(wl + W_IN), DM, DM, MT / 256, 1, DM / 64, F.G, F.G - 1 - F.bid,
                                       (const char*)(ws + WS_MEMN), (const char*)(ws + WS_WKV) + (size_t)l * 1024 * DM * 2, 0, 4, 4, 1, DM / 64, INW / 256 - 1};
                WIN_EPI; fill_rs_table(F, S, RSITE(4 * l + 1)); pg8::gemm_phase<EpiWin, true>(F.lds, S, E, F.tid); }
            LAUNDER(); if (PH_ON(5)) ssm_pass1(args, F, l);
            signal_done_release(F, cnt_word(F, l, CNT_SSM1DONE));
#ifndef ATTN_VAR
#define ATTN_VAR 0
#endif
            if (ATTN_VAR) { LAUNDER(); DEAL_LOOP(F, cnt_word(F, l, CNT_ATTN + 5), AT_UNITS, attn_unit<ATTN_VAR>(args, F, l, u)); xcd_barrier(bar); }
            for (int rep = 0; rep < REPS(8); ++rep) { LAUNDER();
                if (PH_ON(8)) DEAL_LOOP(F, cnt_word(F, l, CNT_ATTN + 5 * rep), AT_UNITS, attn_unit<0>(args, F, l, u));
                REPBAR(8); }
            wait_done(F, cnt_word(F, l, CNT_SSM1DONE), (unsigned)F.G);
            for (int rep = 0; rep < REPS(9); ++rep) { LAUNDER();
                if (PH_ON(9)) DEAL_LOOP_DYN(F, cnt_word(F, l, CNT_SSM2 + 5 * rep), 288, ssm_pass2_unit(args, F, l, u));
                REPBAR(9); }
            for (int rep = 0; rep < REPS(6); ++rep) { LAUNDER();
                if (PH_ON(6)) DEAL_LOOP_DYN(F, cnt_word(F, l, CNT_CONV + 5 * rep), 288, conv_unit(args, F, l, u));
                REPBAR(6); }
            for (int rep = 0; rep < REPS(7); ++rep) { LAUNDER();
                if (PH_ON(7)) DEAL_LOOP_DYN(F, cnt_word(F, l, CNT_GMLP + 5 * rep), 160, gmlp_unit(args, F, l, u));
                REPBAR(7); }
            { LAUNDER(); const int cv0 = BT_EARLY + l * BT_LAYER, cvn = ((l + 1 < DEPTH ? BT_LAYER : BT_LAYER - BT_EARLY)) / CV_PER;
              DEAL_LOOP_DYN(F, cnt_word(F, l, CNT_CVT), cvn, cvt_unit(args, F, cv0 + u * CV_PER)); }
        }
        SEAM(pb + 5);
        if (PH_ON(3) && IN(pb + 7)) for (int rep = 0; rep < (REPS(3) > REPS(17) ? REPS(3) : REPS(17)); ++rep) { LAUNDER(); pg8::Sched S{(const char*)(ws + WS_MIX), (const char*)(wl + W_OUT), DM, DM, NP / 256, DM / 256, DM / 64, F.G, F.bid,
                                       (const char*)(ws + WS_MIX) + (size_t)NP * DM * 2, (const char*)(wl + W_OUT), NP / 256, (rep && REPS(20) > 1) ? 0 : NS / 256, DM / 256, 4, DM / 64 / 4};
            EpiResid E{ws, rep ? 0.f : 1.f, rep ? 16 : 4 * l + 2}; pg8::gemm_phase<EpiResid, true>(F.lds, S, E, F.tid); do { if (rep == 0 && (REPMASK & 0xF0008)) xcd_barrier(bar); } while (0); }
        SEAM(pb + 7);
        if (PH_ON(1) && IN(pb + 8)) for (int rep = 0; rep < REPS(1); ++rep) { LAUNDER(); norm_phase<0>(args, F, rep ? 0 : 4, 1.f, RSITE(4 * l + 2), PSITE(4 * l + 2)); REPBAR(1); }
        SEAM(pb + 8);
        if (PH_ON(10) && IN(pb + 9)) for (int rep = 0; rep < REPS(10); ++rep) { LAUNDER(); pg8::Sched S{(const char*)(ws + WS_X), (const char*)(wl + W_Q), DM, DM, MT / 256, XW / 256, DM / 64, F.G, F.bid, nullptr, nullptr, 0, 0, 0, 0, 0};
            fill_rs_table(F, S, RSITE(4 * l + 2)); EpiQ E{(bf16*)(ws + WS_Q), RS_LDS}; pg8::gemm_phase<EpiQ, true>(F.lds, S, E, F.tid); REPBAR(10); }
        SEAM(pb + 9);
        if (PH_ON(11) && IN(pb + 10)) for (int rep = 0; rep < REPS(11); ++rep) { LAUNDER(); DEAL_LOOP(F, cnt_word(F, l, CNT_XATTN + 5 * rep), 256, xattn_unit(args, F, l, u)); REPBAR(11); }
        SEAM(pb + 10);
        if (PH_ON(3) && IN(pb + 11)) for (int rep = 0; rep < (REPS(3) > REPS(18) ? REPS(3) : REPS(18)); ++rep) { LAUNDER(); pg8::Sched S{(const char*)(ws + WS_OX), (const char*)(wl + W_O), XW, XW, NP / 256, DM / 256, XW / 64, F.G, F.bid,
                                        (const char*)(ws + WS_OX) + (size_t)NP * XW * 2, (const char*)(wl + W_O), NP / 256, (rep && REPS(20) > 1) ? 0 : NS / 256, DM / 256, 2, XW / 64 / 2};
            EpiResid E{ws, rep ? 0.f : 1.f, rep ? 16 : 4 * l + 3}; pg8::gemm_phase<EpiResid, true>(F.lds, S, E, F.tid); do { if (rep == 0 && (REPMASK & 0xF0008)) xcd_barrier(bar); } while (0); }
        SEAM(pb + 11);
        if (PH_ON(1) && IN(pb + 12)) for (int rep = 0; rep < REPS(1); ++rep) { LAUNDER(); norm_phase<0>(args, F, rep ? 0 : 2, 1.f, RSITE(4 * l + 3), PSITE(4 * l + 3)); REPBAR(1); }
        SEAM(pb + 12);
        if (PH_ON(2) && IN(pb + 13)) for (int rep = 0; rep < REPS(2); ++rep) { LAUNDER(); pg8::Sched S{(const char*)(ws + WS_X), (const char*)(wl + W_GU2), DM, DM, MT / 256, 2 * DFF / 256, DM / 64, F.G, F.bid, nullptr, nullptr, 0, 0, 0, 0, 0};
            fill_rs_table(F, S, RSITE(4 * l + 3)); EpiSwiGLU E{(bf16*)(ws + WS_ACT), RS_LDS}; pg8::gemm_phase<EpiSwiGLU, true>(F.lds, S, E, F.tid); REPBAR(2); }
        SEAM(pb + 13);
        if (PH_ON(3) && IN(pb + 14)) for (int rep = 0; rep < (REPS(3) > REPS(19) ? REPS(3) : REPS(19)); ++rep) { LAUNDER(); pg8::Sched S{(const char*)(ws + WS_ACT), (const char*)(wl + W_D2), ALD, ALD, NP / 256, DM / 256, DFF / 64, F.G, F.bid,
                                        (const char*)(ws + WS_ACT) + (size_t)NP * ALD * 2, (const char*)(wl + W_D2), NP / 256, (rep && REPS(20) > 1) ? 0 : NS / 256, DM / 256, 8, DFF / 64 / 8};
            EpiResid E{ws, rep ? 0.f : 0.5f, rep ? 16 : 4 * l + 4}; pg8::gemm_phase<EpiResid, true>(F.lds, S, E, F.tid); do { if (rep == 0 && (REPMASK & 0xF0008)) xcd_barrier(bar); } while (0); }
        SEAM(pb + 14);
    }
#undef wl
    if (PH_ON(12) && IN(PH_FINAL)) { LAUNDER(); norm_phase<2>(args, F, 8, 0.5f, nullptr, nullptr); }
#undef IN
#undef SEAM
#undef X
#undef RSITE
#undef PSITE
#undef RS_LDS
}

extern "C" void kernel_launch(void* const* d_in, const int* in_sizes, int n_in, void* d_out, int out_size, void* d_ws, size_t ws_size, hipStream_t stream) {
    static int grid = 0;
    if (grid == 0) {
        if (n_in != N_IN || (size_t)out_size != O_END || ws_size < WS_END) { fprintf(stderr, "kernel_launch: unexpected shapes: n_in %d out %d (want %zu) ws %zu (want %zu); nothing launched\n", n_in, out_size, (size_t)O_END, ws_size, (size_t)WS_END); grid = -1; return; }
        int dev = 0, cus = 0, per_cu = 0;
        if (hipGetDevice(&dev) != hipSuccess || hipDeviceGetAttribute(&cus, hipDeviceAttributeMultiprocessorCount, dev) != hipSuccess) { grid = -1; return; }
        if (hipFuncSetAttribute((const void*)fwd, hipFuncAttributeMaxDynamicSharedMemorySize, LDS_BYTES) != hipSuccess) { fprintf(stderr, "kernel_launch: hipFuncSetAttribute failed\n"); grid = -1; return; }
        if (hipOccupancyMaxActiveBlocksPerMultiprocessor(&per_cu, (const void*)fwd, NTHR, LDS_BYTES) != hipSuccess || per_cu < 1) fprintf(stderr, "kernel_launch: occupancy query reports %d blocks per CU\n", per_cu);
        (void)hipGetLastError();
        grid = cus;
    }
    if (grid < 0) return;
    (void)hipMemsetAsync((char*)d_ws + WS_CTL, 0, CTL_ZERO_BYTES, stream);
    Args a{};
    for (int i = 0; i < N_IN; ++i) a.in[i] = (const float*)d_in[i];
    a.out = (float*)d_out; a.ws = (unsigned char*)d_ws;
#if MK_MULTI
    for (int p = 0; p < N_PHASES; ++p) { a.ph_lo = p; a.ph_hi = p + 1; hipLaunchKernelGGL(fwd, dim3(grid), dim3(NTHR), LDS_BYTES, stream, a); }
#else
    a.ph_lo = 0; a.ph_hi = N_PHASES;
    hipLaunchKernelGGL(fwd, dim3(grid), dim3(NTHR), LDS_BYTES, stream, a);
#endif
    const hipError_t le = hipPeekAtLastError();
    if (le != hipSuccess) fprintf(stderr, "kernel_launch: launch failed: %s\n", hipGetErrorName(le));
}
```
